# Optimizing an MI355X kernel written in HIP

```python
import math
import functools
import jax
import jax.numpy as jnp
from jax import lax
import numpy as np

D_MODEL = 1024
BATCH = 4
SEQ = 4096
DEPTH = 1
DEC_BATCH = 128
DEC_SEQ = 4
PAST_LEN = 2048
PAGE_SIZE = 128

SSM_WIDTH = D_MODEL // 2
SSM_GROUP_CH = 16
SSM_GROUPS = SSM_WIDTH // SSM_GROUP_CH
SSM_STATE = 64
ATTN_WIDTH = D_MODEL - SSM_WIDTH
ATTN_HEAD_DIM = 64
ATTN_V_DIM = 2 * ATTN_HEAD_DIM
ATTN_HEADS = ATTN_WIDTH // ATTN_V_DIM
IN_PROJ_COLS = SSM_WIDTH + 3 * ATTN_WIDTH
Q_BLOCK = 128
N_MEM = 256
CA_HEADS = 4
CA_HEAD_DIM = D_MODEL // CA_HEADS
FFN_HIDDEN = ((8 * D_MODEL // 3 + 127) // 128) * 128
CONV_WIDTH = 3
NORM_EPS = 1e-6

kernel_name = 'hymba_s5_diffattn_convffn_step'


def rms_norm(x, g):
    xf = x.astype(jnp.float32)
    y = xf * lax.rsqrt(jnp.mean(xf * xf, axis=-1, keepdims=True) + NORM_EPS)
    return (y * g.astype(jnp.float32)).astype(x.dtype)


def alibi_slopes(n_heads):
    return 2.0 ** (-8.0 * jnp.arange(1, n_heads + 1, dtype=jnp.float32) / n_heads)


def lambda_init(layer):
    return 0.8 - 0.6 * math.exp(-0.3 * layer)


def _complex_affine_combine(e1, e2):
    a1r, a1i, b1r, b1i = e1
    a2r, a2i, b2r, b2i = e2
    return (a1r * a2r - a1i * a2i,
            a1r * a2i + a1i * a2r,
            a2r * b1r - a2i * b1i + b2r,
            a2r * b1i + a2i * b1r + b2i)


def s5_mixer(u, h0_re, h0_im, p):
    f32 = jnp.float32
    bsz, t, _ = u.shape
    uf = u.astype(f32).reshape(bsz, t, SSM_GROUPS, SSM_GROUP_CH)
    dt = jnp.exp(p['ssm_log_dt'].astype(f32))[:, None]
    a_re = p['ssm_a_re'].astype(f32)
    a_im = p['ssm_a_im'].astype(f32)
    mag = jnp.exp(a_re * dt)
    lb_re = mag * jnp.cos(a_im * dt)
    lb_im = mag * jnp.sin(a_im * dt)
    den = a_re * a_re + a_im * a_im
    n_re = lb_re - 1.0
    f_re = (n_re * a_re + lb_im * a_im) / den
    f_im = (lb_im * a_re - n_re * a_im) / den
    b_re = p['ssm_b_re'].astype(f32)
    b_im = p['ssm_b_im'].astype(f32)
    bb_re = f_re[..., None] * b_re - f_im[..., None] * b_im
    bb_im = f_re[..., None] * b_im + f_im[..., None] * b_re
    bu_re = jnp.einsum('btgc,gpc->btgp', uf, bb_re)
    bu_im = jnp.einsum('btgc,gpc->btgp', uf, bb_im)
    dec_re = jnp.broadcast_to(lb_re, bu_re.shape)
    dec_im = jnp.broadcast_to(lb_im, bu_im.shape)
    acc_re, acc_im, s_re, s_im = lax.associative_scan(
        _complex_affine_combine, (dec_re, dec_im, bu_re, bu_im), axis=1)
    h0r = h0_re.astype(f32)[:, None]
    h0i = h0_im.astype(f32)[:, None]
    h_re = acc_re * h0r - acc_im * h0i + s_re
    h_im = acc_re * h0i + acc_im * h0r + s_im
    y = (jnp.einsum('btgp,gcp->btgc', h_re, p['ssm_c_re'].astype(f32))
         - jnp.einsum('btgp,gcp->btgc', h_im, p['ssm_c_im'].astype(f32))
         + p['ssm_d'].astype(f32) * uf)
    g = jax.nn.gelu(y.reshape(bsz, t, SSM_WIDTH))
    out = g * jax.nn.sigmoid(g @ p['ssm_glu_w'].astype(f32))
    return out.astype(u.dtype), h_re[:, -1], h_im[:, -1]


def diff_attn_core(q, k, v, q_pos, k_pos, lam):
    s = jnp.einsum('bqhid,bkhid->bhiqk', q, k).astype(jnp.float32) * (ATTN_HEAD_DIM ** -0.5)
    rel = q_pos[:, None] - k_pos[None, :]
    bias = -alibi_slopes(ATTN_HEADS)[:, None, None, None] * rel.astype(jnp.float32)
    s = jnp.where(rel >= 0, s + bias, -jnp.inf)
    pr = jax.nn.softmax(s, axis=-1)
    a = pr[:, :, 0] - lam * pr[:, :, 1]
    return jnp.einsum('bhqk,bkhd->bqhd', a.astype(v.dtype), v)


def attend_prompt(q, k, v, lam):
    bsz, t = q.shape[:2]
    nb = t // Q_BLOCK
    pos = jnp.arange(t, dtype=jnp.int32)
    q_blocks = q.reshape((bsz, nb, Q_BLOCK) + q.shape[2:]).swapaxes(0, 1)
    pos_blocks = pos.reshape(nb, Q_BLOCK)
    out = lax.map(lambda qp: diff_attn_core(qp[0], k, v, qp[1], pos, lam), (q_blocks, pos_blocks))
    return out.swapaxes(0, 1).reshape(bsz, t, ATTN_HEADS, ATTN_V_DIM)


def attend_sample(q, k, v, lam, past_k, past_v):
    t = q.shape[1]
    past = past_k.shape[1]
    k_all = jnp.concatenate([past_k.astype(k.dtype), k], axis=1)
    v_all = jnp.concatenate([past_v.astype(v.dtype), v], axis=1)
    k_pos = jnp.arange(past + t, dtype=jnp.int32)
    q_pos = past + jnp.arange(t, dtype=jnp.int32)
    return diff_attn_core(q, k_all, v_all, q_pos, k_pos, lam)


def memory_kv(mem, p):
    bsz, m, _ = mem.shape
    mn = rms_norm(mem, p['mem_norm_g'])
    mk = rms_norm((mn @ p['ca_wk']).reshape(bsz, m, CA_HEADS, CA_HEAD_DIM), p['ca_k_norm_g'])
    mv = (mn @ p['ca_wv']).reshape(bsz, m, CA_HEADS, CA_HEAD_DIM)
    return mk, mv


def layer_forward(x, p, layer, h0_re, h0_im, conv_prev, mem_k, mem_v, attend):
    f32 = jnp.float32
    bsz, t, _ = x.shape
    xn = rms_norm(x, p['ln1_g'])
    proj = xn @ p['w_in']
    u = proj[..., :SSM_WIDTH]
    q = proj[..., SSM_WIDTH:SSM_WIDTH + ATTN_WIDTH].reshape(bsz, t, ATTN_HEADS, 2, ATTN_HEAD_DIM)
    k = proj[..., SSM_WIDTH + ATTN_WIDTH:SSM_WIDTH + 2 * ATTN_WIDTH].reshape(bsz, t, ATTN_HEADS, 2, ATTN_HEAD_DIM)
    v = proj[..., SSM_WIDTH + 2 * ATTN_WIDTH:].reshape(bsz, t, ATTN_HEADS, ATTN_V_DIM)
    ssm_out, h_re, h_im = s5_mixer(u, h0_re, h0_im, p)
    q = rms_norm(q, p['q_norm_g'])
    k = rms_norm(k, p['k_norm_g'])
    lam0 = lambda_init(layer)
    lam = (jnp.exp(jnp.sum(p['lam_q1'].astype(f32) * p['lam_k1'].astype(f32)))
           - jnp.exp(jnp.sum(p['lam_q2'].astype(f32) * p['lam_k2'].astype(f32))) + lam0)
    o = attend(q, k, v, lam)
    o = rms_norm(o, p['subln_g']) * (1.0 - lam0)
    mixed = jnp.concatenate([ssm_out, o.reshape(bsz, t, ATTN_WIDTH)], axis=-1)
    x = x + mixed @ p['w_out']
    xn = rms_norm(x, p['ln2_g'])
    cq = rms_norm((xn @ p['ca_wq']).reshape(bsz, t, CA_HEADS, CA_HEAD_DIM), p['ca_q_norm_g'])
    s = jnp.einsum('bqhd,bmhd->bhqm', cq, mem_k.astype(cq.dtype)).astype(f32) * (CA_HEAD_DIM ** -0.5)
    pr = jax.nn.softmax(s, axis=-1).astype(x.dtype)
    co = jnp.einsum('bhqm,bmhd->bqhd', pr, mem_v.astype(x.dtype)).reshape(bsz, t, D_MODEL)
    x = x + co @ p['ca_wo']
    xn = rms_norm(x, p['ln3_g'])
    hg = xn @ p['ffn_wg']
    buf = jnp.concatenate([conv_prev.astype(hg.dtype), hg], axis=1)
    w = p['ffn_conv_w']
    conv = p['ffn_conv_b'] + w[0] * buf[:, 0:t]
    for j in range(1, CONV_WIDTH):
        conv = conv + w[j] * buf[:, j:j + t]
    x = x + (jax.nn.silu(conv) * (xn @ p['ffn_wv'])) @ p['ffn_wd']
    return x, k, v, h_re, h_im, buf[:, t:]


def setup_inputs(seed: int = 0) -> dict:
    key = jax.random.key(seed)
    keys = jax.random.split(key, 48)
    counter = [0]

    def nxt():
        kk = keys[counter[0]]
        counter[0] += 1
        return kk

    def nrm(shape, scale):
        return scale * jax.random.normal(nxt(), shape, jnp.float32)

    def gain(n):
        return 1.0 + nrm((DEPTH, n), 0.02)

    n_pages = PAST_LEN // PAGE_SIZE
    n_phys = (5 * DEC_BATCH * n_pages + 3) // 4
    a_im0 = math.pi * jnp.arange(SSM_STATE, dtype=jnp.float32)
    return {
        'x_prompt': nrm((BATCH, SEQ, D_MODEL), 1.0),
        'x_sample': nrm((DEC_BATCH, DEC_SEQ, D_MODEL), 1.0),
        'mem_prompt': nrm((BATCH, N_MEM, D_MODEL), 1.0),
        'cache_k': nrm((DEPTH, n_phys, PAGE_SIZE, ATTN_HEADS, 2, ATTN_HEAD_DIM), 1.0),
        'cache_v': nrm((DEPTH, n_phys, PAGE_SIZE, ATTN_HEADS, ATTN_V_DIM), 1.0),
        'page_table': jax.random.permutation(nxt(), n_phys)[:DEC_BATCH * n_pages].reshape(DEC_BATCH, n_pages).astype(jnp.int32),
        'state_ssm_re': nrm((DEPTH, DEC_BATCH, SSM_GROUPS, SSM_STATE), 0.1),
        'state_ssm_im': nrm((DEPTH, DEC_BATCH, SSM_GROUPS, SSM_STATE), 0.1),
        'state_conv': nrm((DEPTH, DEC_BATCH, CONV_WIDTH - 1, FFN_HIDDEN), 1.0),
        'cache_mem_k': nrm((DEPTH, DEC_BATCH, N_MEM, CA_HEADS, CA_HEAD_DIM), 1.0),
        'cache_mem_v': nrm((DEPTH, DEC_BATCH, N_MEM, CA_HEADS, CA_HEAD_DIM), 1.0),
        'ln1_g': gain(D_MODEL),
        'w_in': nrm((DEPTH, D_MODEL, IN_PROJ_COLS), D_MODEL ** -0.5),
        'ssm_a_re': -0.5 + nrm((DEPTH, SSM_GROUPS, SSM_STATE), 0.01),
        'ssm_a_im': a_im0 + nrm((DEPTH, SSM_GROUPS, SSM_STATE), 0.01),
        'ssm_b_re': nrm((DEPTH, SSM_GROUPS, SSM_STATE, SSM_GROUP_CH), (2 * SSM_GROUP_CH) ** -0.5),
        'ssm_b_im': nrm((DEPTH, SSM_GROUPS, SSM_STATE, SSM_GROUP_CH), (2 * SSM_GROUP_CH) ** -0.5),
        'ssm_c_re': nrm((DEPTH, SSM_GROUPS, SSM_GROUP_CH, SSM_STATE), (2 * SSM_STATE) ** -0.5),
        'ssm_c_im': nrm((DEPTH, SSM_GROUPS, SSM_GROUP_CH, SSM_STATE), (2 * SSM_STATE) ** -0.5),
        'ssm_d': nrm((DEPTH, SSM_GROUPS, SSM_GROUP_CH), 1.0),
        'ssm_log_dt': jax.random.uniform(nxt(), (DEPTH, SSM_GROUPS), jnp.float32, math.log(1e-3), math.log(1e-1)),
        'ssm_glu_w': nrm((DEPTH, SSM_WIDTH, SSM_WIDTH), SSM_WIDTH ** -0.5),
        'q_norm_g': gain(ATTN_HEAD_DIM),
        'k_norm_g': gain(ATTN_HEAD_DIM),
        'lam_q1': nrm((DEPTH, ATTN_HEAD_DIM), 0.1),
        'lam_k1': nrm((DEPTH, ATTN_HEAD_DIM), 0.1),
        'lam_q2': nrm((DEPTH, ATTN_HEAD_DIM), 0.1),
        'lam_k2': nrm((DEPTH, ATTN_HEAD_DIM), 0.1),
        'subln_g': gain(ATTN_V_DIM),
        'w_out': nrm((DEPTH, SSM_WIDTH + ATTN_WIDTH, D_MODEL), (SSM_WIDTH + ATTN_WIDTH) ** -0.5),
        'ln2_g': gain(D_MODEL),
        'mem_norm_g': gain(D_MODEL),
        'ca_wq': nrm((DEPTH, D_MODEL, D_MODEL), D_MODEL ** -0.5),
        'ca_wk': nrm((DEPTH, D_MODEL, D_MODEL), D_MODEL ** -0.5),
        'ca_wv': nrm((DEPTH, D_MODEL, D_MODEL), D_MODEL ** -0.5),
        'ca_q_norm_g': gain(CA_HEAD_DIM),
        'ca_k_norm_g': gain(CA_HEAD_DIM),
        'ca_wo': nrm((DEPTH, D_MODEL, D_MODEL), D_MODEL ** -0.5),
        'ln3_g': gain(D_MODEL),
        'ffn_wg': nrm((DEPTH, D_MODEL, FFN_HIDDEN), D_MODEL ** -0.5),
        'ffn_wv': nrm((DEPTH, D_MODEL, FFN_HIDDEN), D_MODEL ** -0.5),
        'ffn_conv_w': nrm((DEPTH, CONV_WIDTH, FFN_HIDDEN), CONV_WIDTH ** -0.5),
        'ffn_conv_b': nrm((DEPTH, FFN_HIDDEN), 0.01),
        'ffn_wd': nrm((DEPTH, FFN_HIDDEN, D_MODEL), FFN_HIDDEN ** -0.5),
    }


def reference(x_prompt, x_sample, mem_prompt, cache_k, cache_v, page_table,
              state_ssm_re, state_ssm_im, state_conv, cache_mem_k, cache_mem_v,
              ln1_g, w_in, ssm_a_re, ssm_a_im, ssm_b_re, ssm_b_im, ssm_c_re, ssm_c_im,
              ssm_d, ssm_log_dt, ssm_glu_w, q_norm_g, k_norm_g, lam_q1, lam_k1, lam_q2, lam_k2,
              subln_g, w_out, ln2_g, mem_norm_g, ca_wq, ca_wk, ca_wv, ca_q_norm_g, ca_k_norm_g,
              ca_wo, ln3_g, ffn_wg, ffn_wv, ffn_conv_w, ffn_conv_b, ffn_wd):
    y_prompt, y_sample = x_prompt, x_sample
    n_prompt, n_dec = x_prompt.shape[0], x_sample.shape[0]
    (k_p, v_p, k_s, v_s, hr_p, hi_p, hr_s, hi_s, c_p, c_s, mk_p, mv_p) = ([] for _ in range(12))
    for l in range(DEPTH):
        p = {
            'ln1_g': ln1_g[l], 'w_in': w_in[l],
            'ssm_a_re': ssm_a_re[l], 'ssm_a_im': ssm_a_im[l],
            'ssm_b_re': ssm_b_re[l], 'ssm_b_im': ssm_b_im[l],
            'ssm_c_re': ssm_c_re[l], 'ssm_c_im': ssm_c_im[l],
            'ssm_d': ssm_d[l], 'ssm_log_dt': ssm_log_dt[l], 'ssm_glu_w': ssm_glu_w[l],
            'q_norm_g': q_norm_g[l], 'k_norm_g': k_norm_g[l],
            'lam_q1': lam_q1[l], 'lam_k1': lam_k1[l], 'lam_q2': lam_q2[l], 'lam_k2': lam_k2[l],
            'subln_g': subln_g[l], 'w_out': w_out[l],
            'ln2_g': ln2_g[l], 'mem_norm_g': mem_norm_g[l],
            'ca_wq': ca_wq[l], 'ca_wk': ca_wk[l], 'ca_wv': ca_wv[l],
            'ca_q_norm_g': ca_q_norm_g[l], 'ca_k_norm_g': ca_k_norm_g[l], 'ca_wo': ca_wo[l],
            'ln3_g': ln3_g[l], 'ffn_wg': ffn_wg[l], 'ffn_wv': ffn_wv[l],
            'ffn_conv_w': ffn_conv_w[l], 'ffn_conv_b': ffn_conv_b[l], 'ffn_wd': ffn_wd[l],
        }
        mem_k, mem_v = memory_kv(mem_prompt, p)
        zeros_h = jnp.zeros((n_prompt, SSM_GROUPS, SSM_STATE), jnp.float32)
        zeros_c = jnp.zeros((n_prompt, CONV_WIDTH - 1, FFN_HIDDEN), x_prompt.dtype)
        y_prompt, kp, vp, hrp, hip, cp = layer_forward(
            y_prompt, p, l, zeros_h, zeros_h, zeros_c, mem_k, mem_v, attend_prompt)
        past_k = cache_k[l][page_table].reshape(n_dec, -1, ATTN_HEADS, 2, ATTN_HEAD_DIM)
        past_v = cache_v[l][page_table].reshape(n_dec, -1, ATTN_HEADS, ATTN_V_DIM)
        attend = functools.partial(attend_sample, past_k=past_k, past_v=past_v)
        y_sample, ks, vs, hrs, his, cs = layer_forward(
            y_sample, p, l, state_ssm_re[l], state_ssm_im[l], state_conv[l],
            cache_mem_k[l], cache_mem_v[l], attend)
        k_p.append(kp)
        v_p.append(vp)
        k_s.append(ks)
        v_s.append(vs)
        hr_p.append(hrp)
        hi_p.append(hip)
        hr_s.append(hrs)
        hi_s.append(his)
        c_p.append(cp)
        c_s.append(cs)
        mk_p.append(mem_k)
        mv_p.append(mem_v)
    return (y_prompt, y_sample,
            jnp.stack(k_p), jnp.stack(v_p), jnp.stack(k_s), jnp.stack(v_s),
            jnp.stack(hr_p), jnp.stack(hi_p), jnp.stack(hr_s), jnp.stack(hi_s),
            jnp.stack(c_p), jnp.stack(c_s), jnp.stack(mk_p), jnp.stack(mv_p))
```

```cpp
#include <hip/hip_runtime.h>
#include <cstdio>
#include <cstdint>
#include <cmath>
#include <hip/hip_bf16.h>
#define DBG_KV 1.0f
#define DBG_MKV 1.0f
#define DBG_SSM 1.0f
#define DBG_CONV 1.0f
#define DBG_Y 1.0f
namespace pg8 {
#define PG8_LAS __attribute__((address_space(3)))
typedef unsigned short bf16_t;
typedef short bf16x8 __attribute__((ext_vector_type(8)));
typedef float f32x4 __attribute__((ext_vector_type(4)));
typedef unsigned u32x4 __attribute__((ext_vector_type(4)));
constexpr int BM = 256, BK = 64, HALF = 128, HTB = HALF * BK * 2  , STAGE_BYTES = 8 * HTB, NXCD = 8, WGM = 8;

__host__ __device__ __forceinline__ int lds_byte(int r, int c) { const int st = (r >> 4) * 2 + (c >> 5), rr = r & 15, cc = c & 31, ob = rr * 64 + cc * 2; return st * 1024 + (ob ^ (((ob >> 9) & 1) << 5)); }
__host__ __device__ __forceinline__ void stage_rc(int b, int& R, int& C) { const int st = b / 1024, sb = b % 1024, swz = sb ^ (((sb >> 9) & 1) << 5); R = (st >> 1) * 16 + swz / 64; C = (st & 1) * 32 + (swz % 64) / 2; }
__host__ __device__ __forceinline__ int perm32(int rho) { const int n = rho >> 4, i = rho & 15; return 8 * (i >> 2) + 4 * n + (i & 3); }

struct Unit { int pm, pn; };
struct Gemm { const bf16_t* A; const bf16_t* Bt; int M, N, K; int lda = 0; size_t akstep = 0; };

struct StaticOrder {
    int nM, nN, nwg, G, c;
    __host__ __device__ void init(int M, int N, int G_, int c_) { nM = M / BM; nN = N / BM; nwg = nM * nN; G = G_; c = c_; }
    __host__ __device__ bool next(int i, Unit& u) const {
        const long L = (long)i * G + c; if (L >= nwg) return false;
        int wgid = (int)L; { const int q = nwg / NXCD, r = nwg % NXCD, xcd = wgid % NXCD, off = wgid / NXCD; wgid = (xcd < r ? xcd * (q + 1) : r * (q + 1) + (xcd - r) * q) + off; }
        const int nig = WGM * nN, gid = wgid / nig, fm = gid * WGM, gsz = (nM - fm) < WGM ? (nM - fm) : WGM;
        u.pm = fm + ((wgid % nig) % gsz); u.pn = (wgid % nig) / gsz; return true;
    }
    __device__ __forceinline__ void a_ready(const Unit&) const {}
    __device__ __forceinline__ void done(const Unit&) const {}
};

typedef float f32x2cv __attribute__((ext_vector_type(2))); typedef __bf16 bf16x2cv __attribute__((ext_vector_type(2)));
__device__ __forceinline__ unsigned cvt_pk_bf16(float lo, float hi) { const f32x2cv v = {lo, hi}; return __builtin_bit_cast(unsigned, __builtin_convertvector(v, bf16x2cv)); }
template <class Epi, class Sched, bool ALIGN_EPI = false, bool SP2 = false>
__device__ __forceinline__ void gemm_phase(PG8_LAS unsigned char* lds, const Gemm g, const Sched& S, const Epi& E) {
    const int tid = threadIdx.x, wid = __builtin_amdgcn_readfirstlane(tid >> 6), lane = tid & 63, wr = wid >> 2, wc = wid & 3, fr = lane & 15, fq = lane >> 4;
    const int K = g.K, nt = K / BK, lda = g.lda ? g.lda : K;
    unsigned voffA[2], voffB[2];
#pragma unroll
    for (int i = 0; i < 2; ++i) { int R, C; stage_rc(tid * 16 + i * 8192, R, C); const int Rb = Epi::PERM ? ((R & ~31) + perm32(R & 31)) : R;
        voffA[i] = (unsigned)(R * lda + C) * 2u; voffB[i] = (unsigned)(Rb * K + C) * 2u; }
    const size_t akstep = g.akstep ? g.akstep : (size_t)(BK * 2), ahstep = (size_t)HALF * lda * 2, atstep = 2 * ahstep;
    const size_t kstep = (size_t)(BK * 2);
    const size_t hstep = (size_t)HALF * K * 2;
    const size_t tstep = 2 * hstep;
    const unsigned ldsw = (unsigned)wid * 1024u;
    const int aoff = lds_byte(wr * 64 + fr, fq * 8), boff = lds_byte(wc * 32 + fr, fq * 8);
#define PG8_SA(b, h) (((b) * 2 + (h)) * HTB)
#define PG8_SB(b, h) ((4 + (b) * 2 + (h)) * HTB)
#define PG8_STAGE(bufoff, gbase, voff) do { _Pragma("unroll") for (int _i = 0; _i < 2; ++_i) \
        __builtin_amdgcn_global_load_lds((const unsigned*)((const char*)(gbase) + (voff)[_i]), (PG8_LAS unsigned*)(lds + (bufoff) + ldsw + _i * 8192), 16, 0, 0); } while (0)
#define PG8_LDA(dst, b, h) do { _Pragma("unroll") for (int m = 0; m < 4; ++m) _Pragma("unroll") for (int k = 0; k < 2; ++k) dst[m][k] = *(const PG8_LAS bf16x8*)(lds + PG8_SA(b, h) + aoff + m * 2048 + k * 1024); } while (0)
#define PG8_LDB(dst, b, h) do { _Pragma("unroll") for (int n = 0; n < 2; ++n) _Pragma("unroll") for (int k = 0; k < 2; ++k) dst[n][k] = *(const PG8_LAS bf16x8*)(lds + PG8_SB(b, h) + boff + n * 2048 + k * 1024); } while (0)
#define PG8_MMA(ai, bj, At, Bt) do { __builtin_amdgcn_s_setprio(1); _Pragma("unroll") for (int m = 0; m < 4; ++m) _Pragma("unroll") for (int n = 0; n < 2; ++n) _Pragma("unroll") for (int k = 0; k < 2; ++k) \
        acc[ai][bj][m][n] = __builtin_amdgcn_mfma_f32_16x16x32_bf16(Bt[n][k], At[m][k], acc[ai][bj][m][n], 0, 0, 0); __builtin_amdgcn_s_setprio(0); } while (0)
#define PG8_WAIT_V(n) asm volatile("s_waitcnt vmcnt(" #n ")" ::: "memory")
#define PG8_WAIT_L(n) asm volatile("s_waitcnt lgkmcnt(" #n ")" ::: "memory")
#define PG8_BAR __builtin_amdgcn_s_barrier()
#define PG8_SCHED __builtin_amdgcn_sched_barrier(0)
    Unit cur, nxt; int ui = 0;
    if (!S.next(0, cur)) return;
    f32x4 acc[2][2][4][2];
#pragma unroll
    for (int a = 0; a < 2; ++a)
#pragma unroll
        for (int b = 0; b < 2; ++b)
#pragma unroll
            for (int m = 0; m < 4; ++m)
#pragma unroll
                for (int n = 0; n < 2; ++n) acc[a][b][m][n] = (f32x4){0.f, 0.f, 0.f, 0.f};
    bf16x8 At[4][2], B0[2][2], B1[2][2];
    const char* cA = (const char*)g.A + (size_t)cur.pm * atstep; const char* cB = (const char*)g.Bt + (size_t)cur.pn * tstep;
    S.a_ready(cur);
    if constexpr (SP2) {
        PG8_STAGE(PG8_SB(0, 0), cB, voffB); PG8_STAGE(PG8_SB(0, 1), cB + hstep, voffB); PG8_STAGE(PG8_SA(0, 0), cA, voffA); PG8_STAGE(PG8_SA(0, 1), cA + ahstep, voffA);
        if (wr == 1) PG8_BAR;
        PG8_WAIT_V(2); PG8_BAR;
        PG8_STAGE(PG8_SB(1, 0), cB + kstep, voffB); PG8_STAGE(PG8_SA(1, 0), cA + akstep, voffA); PG8_STAGE(PG8_SB(1, 1), cB + hstep + kstep, voffB);
        PG8_WAIT_V(6); PG8_BAR;
    } else {
        PG8_STAGE(PG8_SB(0, 0), cB, voffB); PG8_STAGE(PG8_SA(0, 0), cA, voffA); PG8_STAGE(PG8_SB(0, 1), cB + hstep, voffB); PG8_STAGE(PG8_SA(0, 1), cA + ahstep, voffA);
        if (wr == 1) PG8_BAR;
        PG8_WAIT_V(4); PG8_BAR;
        PG8_STAGE(PG8_SB(1, 0), cB + kstep, voffB); PG8_STAGE(PG8_SA(1, 0), cA + akstep, voffA); PG8_STAGE(PG8_SB(1, 1), cB + hstep + kstep, voffB);
        PG8_WAIT_V(6); PG8_BAR;
    }
    for (;;) {
        const bool has_next = S.next(ui + 1, nxt);
        const char* nA = has_next ? (const char*)g.A + (size_t)nxt.pm * atstep : cA; const char* nB = has_next ? (const char*)g.Bt + (size_t)nxt.pn * tstep : cB;
        for (int t = 0; t < nt; t += 2) {
            const bool last = (t == nt - 2);
            const char* a1 = cA + (size_t)(t + 1) * akstep;
            const char* a2 = last ? nA : cA + (size_t)(t + 2) * akstep; const char* b2 = last ? nB : cB + (size_t)(t + 2) * kstep;
            const char* a3 = a2 + akstep; const char* b3 = b2 + kstep;
            if (last && has_next) S.a_ready(nxt);
            if constexpr (SP2) {
            PG8_LDB(B0, 0, 0); PG8_LDB(B1, 0, 1); PG8_SCHED; PG8_LDA(At, 0, 0); PG8_STAGE(PG8_SA(1, 1), a1 + ahstep, voffA);
            PG8_WAIT_V(8); PG8_WAIT_L(0); PG8_BAR; PG8_MMA(0, 0, At, B0); PG8_MMA(0, 1, At, B1); PG8_BAR; PG8_SCHED;
            PG8_LDA(At, 0, 1); PG8_STAGE(PG8_SB(0, 0), b2, voffB); PG8_STAGE(PG8_SB(0, 1), b2 + hstep, voffB); PG8_STAGE(PG8_SA(0, 0), a2, voffA);
            PG8_WAIT_V(8); PG8_WAIT_L(0); PG8_BAR; PG8_MMA(1, 0, At, B0); PG8_MMA(1, 1, At, B1); PG8_BAR; PG8_SCHED;
            PG8_LDB(B0, 1, 0); PG8_LDB(B1, 1, 1); PG8_SCHED; PG8_LDA(At, 1, 0); PG8_STAGE(PG8_SA(0, 1), a2 + ahstep, voffA);
            PG8_WAIT_V(8); PG8_WAIT_L(0); PG8_BAR; PG8_MMA(0, 0, At, B0); PG8_MMA(0, 1, At, B1); PG8_BAR; PG8_SCHED;
            PG8_LDA(At, 1, 1); PG8_STAGE(PG8_SB(1, 0), b3, voffB); PG8_STAGE(PG8_SB(1, 1), b3 + hstep, voffB); PG8_STAGE(PG8_SA(1, 0), a3, voffA);
            PG8_WAIT_V(8); PG8_WAIT_L(0); PG8_BAR; PG8_MMA(1, 0, At, B0); PG8_MMA(1, 1, At, B1); PG8_BAR; PG8_SCHED;
            } else {
            PG8_LDB(B0, 0, 0); PG8_SCHED; PG8_LDA(At, 0, 0); PG8_STAGE(PG8_SA(1, 1), a1 + ahstep, voffA);
            PG8_WAIT_L(8); PG8_BAR; PG8_WAIT_L(0); PG8_MMA(0, 0, At, B0); PG8_BAR; PG8_SCHED;
            PG8_LDB(B1, 0, 1); PG8_STAGE(PG8_SB(0, 0), b2, voffB);
            PG8_BAR; PG8_WAIT_L(0); PG8_MMA(0, 1, At, B1); PG8_BAR;
            PG8_LDA(At, 0, 1); PG8_STAGE(PG8_SA(0, 0), a2, voffA);
            PG8_BAR; PG8_WAIT_L(0); PG8_MMA(1, 0, At, B0); PG8_BAR; PG8_SCHED;
            PG8_STAGE(PG8_SB(0, 1), b2 + hstep, voffB);
            PG8_WAIT_V(6); PG8_BAR; PG8_MMA(1, 1, At, B1); PG8_BAR;
            PG8_LDB(B0, 1, 0); PG8_SCHED; PG8_LDA(At, 1, 0); PG8_STAGE(PG8_SA(0, 1), a2 + ahstep, voffA);
            PG8_WAIT_L(8); PG8_BAR; PG8_WAIT_L(0); PG8_MMA(0, 0, At, B0); PG8_BAR; PG8_SCHED;
            PG8_LDB(B1, 1, 1); PG8_STAGE(PG8_SB(1, 0), b3, voffB);
            PG8_BAR; PG8_WAIT_L(0); PG8_MMA(0, 1, At, B1); PG8_BAR;
            PG8_LDA(At, 1, 1); PG8_STAGE(PG8_SA(1, 0), a3, voffA);
            PG8_BAR; PG8_WAIT_L(0); PG8_MMA(1, 0, At, B0); PG8_BAR; PG8_SCHED;
            PG8_STAGE(PG8_SB(1, 1), b3 + hstep, voffB);
            PG8_WAIT_V(6); PG8_BAR; PG8_MMA(1, 1, At, B1); PG8_BAR;
            }
        }
        if constexpr (ALIGN_EPI) { if (wr == 0) PG8_BAR; }
        if constexpr (!Epi::AFTER_DRAIN) { E(acc, cur, wr, wc, fr, fq); S.done(cur); }
        if (!has_next) break;
#pragma unroll
        for (int a = 0; a < 2; ++a)
#pragma unroll
            for (int b = 0; b < 2; ++b)
#pragma unroll
                for (int m = 0; m < 4; ++m)
#pragma unroll
                    for (int n = 0; n < 2; ++n) acc[a][b][m][n] = (f32x4){0.f, 0.f, 0.f, 0.f};
        cur = nxt; cA = nA; cB = nB; ++ui;
        if constexpr (ALIGN_EPI) { if (wr == 1) PG8_BAR; }
    }
    PG8_WAIT_V(0);
    if constexpr (!ALIGN_EPI) { if (wr == 0) PG8_BAR; }
    PG8_BAR;
    if constexpr (Epi::AFTER_DRAIN) { E.fused(acc, cur, wr, wc, fr, fq, lds, wid, lane); S.done(cur); }
#undef PG8_SA
#undef PG8_SB
#undef PG8_STAGE
#undef PG8_LDA
#undef PG8_LDB
#undef PG8_MMA
#undef PG8_WAIT_V
#undef PG8_WAIT_L
#undef PG8_BAR
#undef PG8_SCHED
}
}
#define LAS __attribute__((address_space(3)))
#define GAS __attribute__((address_space(1)))
typedef unsigned short bf16;
typedef short bf16x8 __attribute__((ext_vector_type(8)));
typedef float f32x4 __attribute__((ext_vector_type(4)));
typedef float f32x2 __attribute__((ext_vector_type(2)));
typedef float f32x16 __attribute__((ext_vector_type(16)));
typedef unsigned u32x4 __attribute__((ext_vector_type(4)));
typedef unsigned u32x2 __attribute__((ext_vector_type(2)));
typedef GAS unsigned gu32;

constexpr int DMODEL = 1024, NBATCH = 4, SEQ = 4096, MP = NBATCH * SEQ, NDEC = 128, DSEQ = 4, MS = NDEC * DSEQ, MTOT = MP + MS;
constexpr int PAST = 2048, PAGE = 128, NPAGES = PAST / PAGE;
constexpr int NG = 32, GC = 16, NST = 64, SSMW = 512, ATW = 512, NH = 4, HD = 64, VD = 128, INCOLS = 2048;
constexpr int NMEM = 256, CAH = 4, CAD = 256, MMEM = NBATCH * NMEM;
constexpr int FF = 2816;
constexpr float EPS = 1e-6f;
constexpr float LOG2E = 1.4426950408889634f;
constexpr float C2 = 0.125f * LOG2E;
constexpr float CA2 = 0.0625f * LOG2E;
constexpr float LAM0 = 0.2f;

constexpr size_t O_YP = 0, O_YS = O_YP + (size_t)MP * DMODEL, O_KP = O_YS + (size_t)MS * DMODEL, O_VP = O_KP + (size_t)MP * 512,
                 O_KS = O_VP + (size_t)MP * 512, O_VS = O_KS + (size_t)MS * 512, O_HRP = O_VS + (size_t)MS * 512, O_HIP = O_HRP + NBATCH * NG * NST,
                 O_HRS = O_HIP + NBATCH * NG * NST, O_HIS = O_HRS + (size_t)NDEC * NG * NST, O_CP = O_HIS + (size_t)NDEC * NG * NST,
                 O_CS = O_CP + (size_t)NBATCH * 2 * FF, O_MK = O_CS + (size_t)NDEC * 2 * FF, O_MV = O_MK + (size_t)MMEM * DMODEL, O_END = O_MV + (size_t)MMEM * DMODEL;
static_assert(O_END == 37984256, "output size");

enum { I_XP = 0, I_XS, I_MEM, I_CK, I_CV, I_PT, I_SRE, I_SIM, I_SCONV, I_CMK, I_CMV, I_LN1, I_WIN, I_ARE, I_AIM, I_BRE, I_BIM, I_CRE, I_CIM, I_D, I_LDT, I_GLU,
       I_QG, I_KG, I_LQ1, I_LK1, I_LQ2, I_LK2, I_SUBLN, I_WOUT, I_LN2, I_MEMG, I_WQ, I_WK, I_WV, I_CAQG, I_CAKG, I_WO, I_LN3, I_WG, I_WVV, I_CONVW, I_CONVB, I_WD, N_IN };
static_assert(N_IN == 44, "inputs");

constexpr size_t MiB = 1u << 20;
constexpr size_t al(size_t x) { return (x + MiB - 1) / MiB * MiB; }
constexpr size_t WS_CTL = 0, CTL_ZERO_BYTES = 1 * MiB;
constexpr size_t WS_WIN = 2 * MiB;
constexpr size_t WS_WKV = WS_WIN + al((size_t)2048 * 1024 * 2);
constexpr size_t WS_GLU = WS_WKV + al((size_t)2048 * 1024 * 2);
constexpr size_t WS_WOUT = WS_GLU + al((size_t)512 * 512 * 2);
constexpr size_t WS_WQ = WS_WOUT + al((size_t)1024 * 1024 * 2);
constexpr size_t WS_WO = WS_WQ + al((size_t)1024 * 1024 * 2);
constexpr size_t WS_WG = WS_WO + al((size_t)1024 * 1024 * 2);
constexpr size_t WS_WV = WS_WG + al((size_t)FF * 1024 * 2);
constexpr size_t WS_WD = WS_WV + al((size_t)FF * 1024 * 2);
constexpr size_t WS_TQ = WS_WD + al((size_t)FF * 1024 * 2);
constexpr size_t WS_PM = WS_TQ + al((size_t)NG * 256 * 384 * 2);
constexpr size_t WS_SSMF = WS_PM + al((size_t)NG * 128 * 256 * 2);
constexpr size_t WS_MN = WS_SSMF + 1 * MiB;
constexpr size_t WS_MKB = WS_MN + al((size_t)MMEM * 1024 * 2);
constexpr size_t WS_MVB = WS_MKB + al((size_t)MMEM * 1024 * 2);
constexpr size_t WS_SS1 = WS_MVB + al((size_t)MMEM * 1024 * 2);
constexpr size_t WS_SS2 = WS_SS1 + al((size_t)MTOT * 16 * 4);
constexpr size_t WS_SSQ = WS_SS2 + al((size_t)MTOT * 16 * 4);
constexpr size_t WS_XN1 = WS_SSQ + 1 * MiB;
constexpr size_t WS_UG = WS_XN1 + al((size_t)MTOT * 1024 * 2);
constexpr size_t WS_QB = WS_UG + al((size_t)MTOT * 512 * 2);
constexpr size_t WS_KB = WS_QB + al((size_t)MTOT * 512 * 2);
constexpr size_t WS_VB = WS_KB + al((size_t)MTOT * 512 * 2);
constexpr size_t WS_O0 = WS_VB + al((size_t)MTOT * 512 * 2);
constexpr size_t WS_O1 = WS_O0 + al((size_t)MTOT * 512 * 2);
constexpr size_t WS_G = WS_O1 + al((size_t)MTOT * 512 * 2);
constexpr size_t WS_MIX = WS_G + al((size_t)MTOT * 512 * 2);
constexpr size_t WS_X1 = WS_MIX + al((size_t)MTOT * 1024 * 2);
constexpr size_t WS_XB1 = WS_X1 + al((size_t)MTOT * 1024 * 4);
constexpr size_t WS_CQ = WS_XB1 + al((size_t)MTOT * 1024 * 2);
constexpr size_t WS_CO = WS_CQ + al((size_t)MTOT * 1024 * 2);
constexpr size_t WS_X2 = WS_CO + al((size_t)MTOT * 1024 * 2);
constexpr size_t WS_XB2 = WS_X2 + al((size_t)MTOT * 1024 * 4);
constexpr size_t WS_HG = WS_XB2 + al((size_t)MTOT * 1024 * 2);
constexpr size_t WS_H = WS_UG;
static_assert(WS_UG + (size_t)MTOT * FF * 2 <= WS_MIX, "h overlay");
constexpr size_t WS_END = WS_HG + al((size_t)MTOT * FF * 2);
constexpr int SF_LBL = 0;
constexpr int SF_LB1 = SF_LBL + NG * 128;
constexpr int SF_BB = SF_LB1 + NG * 128;
constexpr int SF_END = SF_BB + NG * 64 * 16 * 2;
static_assert((size_t)SF_END * 4 <= 1 * MiB, "ssm f32 tables");

constexpr int CW_BAR = 4096;
constexpr int CW_QUEUE2 = 128;
constexpr int CW_QUEUE = 64;

constexpr int RING_BYTES = 131072;
constexpr int MISC_OFF = RING_BYTES + 64;
constexpr int EPI_SCR_OFF = RING_BYTES + 1024;
constexpr int EPI_RS_OFF = EPI_SCR_OFF + 4096;
constexpr int EPI_HALO_OFF = EPI_RS_OFF + 1024;
constexpr int LDS_BYTES = 147456;
static_assert(EPI_HALO_OFF + 6 * 4 * 2 * 32 * 4 <= LDS_BYTES, "LDS map");

__device__ __forceinline__ size_t hidx(size_t r, int c) { return ((size_t)(c >> 6) * MTOT + r) * 64 + (c & 63); }
typedef float f32x2pk __attribute__((ext_vector_type(2))); typedef __bf16 bf16x2pk __attribute__((ext_vector_type(2)));
__device__ __forceinline__ unsigned pk2(float lo, float hi) { const f32x2pk v = {lo, hi}; return __builtin_bit_cast(unsigned, __builtin_convertvector(v, bf16x2pk)); }
__device__ __forceinline__ unsigned f2bf(float f) { return pk2(f, 0.f) & 0xffffu; }
__device__ __forceinline__ float bf2f(unsigned h) { return __builtin_bit_cast(float, h << 16); }
__device__ __forceinline__ float bflo(unsigned w) { return __builtin_bit_cast(float, w << 16); }
__device__ __forceinline__ float bfhi(unsigned w) { return __builtin_bit_cast(float, w & 0xffff0000u); }
#define DPP_F(old, x, ctrl, rmask, bc) __builtin_bit_cast(float, __builtin_amdgcn_update_dpp(__builtin_bit_cast(int, (old)), __builtin_bit_cast(int, (x)), (ctrl), (rmask), 0xf, (bc)))
__device__ __forceinline__ float wave_sum(float v) {
    v += DPP_F(0.f, v, 0x111, 0xf, true); v += DPP_F(0.f, v, 0x112, 0xf, true); v += DPP_F(0.f, v, 0x114, 0xf, true); v += DPP_F(0.f, v, 0x118, 0xf, true);
    v += DPP_F(0.f, v, 0x142, 0xa, false); v += DPP_F(0.f, v, 0x143, 0xc, false);
    return __builtin_bit_cast(float, __builtin_amdgcn_readlane(__builtin_bit_cast(int, v), 63));
}
__device__ __forceinline__ float wave_max(float v) {
    v = fmaxf(v, DPP_F(v, v, 0x111, 0xf, false)); v = fmaxf(v, DPP_F(v, v, 0x112, 0xf, false)); v = fmaxf(v, DPP_F(v, v, 0x114, 0xf, false)); v = fmaxf(v, DPP_F(v, v, 0x118, 0xf, false));
    v = fmaxf(v, DPP_F(v, v, 0x142, 0xa, false)); v = fmaxf(v, DPP_F(v, v, 0x143, 0xc, false));
    return __builtin_bit_cast(float, __builtin_amdgcn_readlane(__builtin_bit_cast(int, v), 63));
}
__device__ __forceinline__ float quad_allsum(float v) { v += DPP_F(0.f, v, 0xB1, 0xf, true); v += DPP_F(0.f, v, 0x4E, 0xf, true); return v; }
__device__ __forceinline__ float oct_allsum(float v) { v = quad_allsum(v); v += DPP_F(0.f, v, 0x141, 0xf, true); return v; }
__device__ __forceinline__ float row_allsum(float v) { v = oct_allsum(v); v += DPP_F(0.f, v, 0x140, 0xf, true); return v; }
#define LDS_WAIT() asm volatile("s_waitcnt lgkmcnt(0)" ::: "memory")
#define VM_WAIT() asm volatile("s_waitcnt vmcnt(0)" ::: "memory")
#define XB_TMO      128
#define XB_XCNT(j)  (256  + 64 * (j))
#define XB_XSUB(j)  (1280 + 64 * (j))
#define XB_XGEN(j)  (2304 + 64 * (j))
#define XB_TOP      3328
#define XB_TOPGEN   3392
#define XCD_BAR_WORDS 3456
#define XB_SPIN_CAP (1u << 18)

__device__ __forceinline__ unsigned xb_ld(unsigned* p)              { return __hip_atomic_load(p, __ATOMIC_RELAXED, __HIP_MEMORY_SCOPE_AGENT); }
__device__ __forceinline__ unsigned xb_add(unsigned* p, unsigned v) { return __hip_atomic_fetch_add(p, v, __ATOMIC_RELAXED, __HIP_MEMORY_SCOPE_AGENT); }
__device__ __forceinline__ unsigned xb_xcc_id() { return (unsigned)__builtin_amdgcn_s_getreg((3 << 11) | 20) & 0xFu; }
#define XB_SPIN(cond, bar) do { unsigned _sp = 0; while (cond) { __builtin_amdgcn_s_sleep(1); \
    if ((++_sp & 255u) == 0u) { if (xb_ld(&(bar)[XB_TMO])) break; if (_sp > XB_SPIN_CAP) { atomicAdd(&(bar)[XB_TMO], 1u); break; } } } } while (0)

struct XcdBarrier {
    unsigned* bar; unsigned x;
    volatile LAS unsigned* st;
};

__device__ __forceinline__ XcdBarrier xcd_barrier_post(unsigned* bar, volatile LAS unsigned* st) {
    XcdBarrier b; b.bar = bar; b.x = xb_xcc_id(); b.st = st;
    if (threadIdx.x == 0) (void)xb_add(&bar[XB_XCNT(b.x)], 1u);
    return b;
}
__device__ __forceinline__ void xcd_barrier_complete(unsigned* bar, unsigned x, unsigned& nloc, unsigned& nx) {
    const unsigned G = gridDim.x * gridDim.y * gridDim.z;
    unsigned sum, cnt, mine, sp = 0u;
    for (;;) {
        sum = 0u; cnt = 0u; mine = 0u;
#pragma unroll
        for (unsigned j = 0; j < 16; ++j) { const unsigned c = xb_ld(&bar[XB_XCNT(j)]); sum += c; cnt += (c > 0u) ? 1u : 0u; mine = (j == x) ? c : mine; }
        if (sum == G) break;
        __builtin_amdgcn_s_sleep(1);
        if ((++sp & 255u) == 0u) { if (xb_ld(&bar[XB_TMO])) break; if (sp > XB_SPIN_CAP) { atomicAdd(&bar[XB_TMO], 1u); break; } }
    }
    nloc = mine > 0u ? mine : 1u; nx = cnt > 0u ? cnt : 1u;
}

__device__ __forceinline__ void xcd_barrier(const XcdBarrier& b) {
    asm volatile("s_waitcnt vmcnt(0)" ::: "memory");
    __syncthreads();
    if (threadIdx.x == 0) {
        unsigned* bar = b.bar;
        __builtin_amdgcn_s_waitcnt(0);
        unsigned nloc = b.st[0], nx = b.st[1];
        if (nloc == 0u) { xcd_barrier_complete(bar, b.x, nloc, nx); b.st[0] = nloc; b.st[1] = nx; }
        const unsigned old = xb_add(&bar[XB_XSUB(b.x)], 1u);
        const unsigned gen = old / nloc;
        if (old + 1u == (gen + 1u) * nloc) {
            __builtin_amdgcn_fence(__ATOMIC_RELEASE, "agent");
            asm volatile("s_waitcnt vmcnt(0)" ::: "memory");
            const unsigned og = xb_add(&bar[XB_TOP], 1u);
            const unsigned tg = og / nx;
            if (og + 1u == (tg + 1u) * nx) xb_add(&bar[XB_TOPGEN], 1u);
            else XB_SPIN(xb_ld(&bar[XB_TOPGEN]) == tg, bar);
            __builtin_amdgcn_fence(__ATOMIC_ACQUIRE, "agent");
            xb_add(&bar[XB_XGEN(b.x)], 1u);
            asm volatile("s_waitcnt vmcnt(0)" ::: "memory");
        } else {
            XB_SPIN(xb_ld(&bar[XB_XGEN(b.x)]) == gen, bar);
            __builtin_amdgcn_fence(__ATOMIC_ACQUIRE, "agent");
            asm volatile("s_waitcnt vmcnt(0)" ::: "memory");
        }
    }
    __syncthreads();
}
__device__ __forceinline__ int colpos(int n0) { const int a = n0 & 255; return (n0 & ~255) + 128 * ((a >> 5) & 1) + 32 * (a >> 6); }
__device__ __forceinline__ void transpose_item(const float* W, int K, int N, bf16* WT, int row_off, LAS float* scr, int item, int lane, const float* kgain = nullptr, int posmode = 0) {
    const int nblk = N / 32, kb = item / nblk, nb = item % nblk, k0 = 64 * kb, n0 = 32 * nb;
    float wv[32];
#pragma unroll
    for (int i = 0; i < 32; ++i) wv[i] = W[(size_t)(k0 + 2 * i + (lane >> 5)) * N + n0 + (lane & 31)];
    if (kgain) {
#pragma unroll
        for (int i = 0; i < 32; ++i) wv[i] *= kgain[k0 + 2 * i + (lane >> 5)]; }
#pragma unroll
    for (int i = 0; i < 32; ++i) scr[(2 * i + (lane >> 5)) * 33 + (lane & 31)] = wv[i];
    LDS_WAIT(); asm volatile("" ::: "memory");
    const int c = lane & 7; const int prow = row_off + (posmode == 0 ? colpos(n0) : 256 * (n0 >> 7) + 32 * ((n0 >> 5) & 3) + (posmode == 2 ? 128 : 0));
#pragma unroll
    for (int j = 0; j < 4; ++j) { const int n = (lane >> 3) + 8 * j; const LAS float* s = scr + (8 * c) * 33 + n;
        u32x4 o; o.x = pk2(s[0 * 33], s[1 * 33]); o.y = pk2(s[2 * 33], s[3 * 33]); o.z = pk2(s[4 * 33], s[5 * 33]); o.w = pk2(s[6 * 33], s[7 * 33]);
        *(GAS u32x4*)(WT + (size_t)(prow + n) * K + k0 + 8 * c) = o; }
    LDS_WAIT(); asm volatile("" ::: "memory");
}
__device__ __forceinline__ void rms_row_to_bf16(const float* xrow, const float* g, bf16* orow, int lane) {
    const GAS f32x4* xr = (const GAS f32x4*)xrow + lane; const GAS f32x4* gr = (const GAS f32x4*)g + lane;
    f32x4 v[4]; float s = 0.f;
#pragma unroll
    for (int j = 0; j < 4; ++j) { v[j] = xr[64 * j]; s += (v[j].x * v[j].x + v[j].y * v[j].y) + (v[j].z * v[j].z + v[j].w * v[j].w); }
    const float rinv = 1.f / sqrtf(wave_sum(s) * (1.f / DMODEL) + EPS);
    GAS unsigned long long* o8 = (GAS unsigned long long*)orow + lane;
#pragma unroll
    for (int j = 0; j < 4; ++j) { const f32x4 gg = gr[64 * j]; const f32x4 y = v[j] * rinv * gg;
        o8[64 * j] = (unsigned long long)pk2(y.x, y.y) | ((unsigned long long)pk2(y.z, y.w) << 32); }
}
__device__ __forceinline__ void ssm_tables(const float* are_, const float* aim_, const float* bre_, const float* bim_, const float* cre_, const float* cim_, const float* dd_, const float* ldt_,
                                           bf16* TQ, bf16* PM, float* SF, int g, int part, LAS float* L, int tid) {
    LAS float* lbp = L;
    LAS float* Bb = L + 17 * 128;
    LAS float* Kt = Bb + 64 * 32;
    LAS float* Cc = Kt + 16 * 256;
    const float dtf = expf(ldt_[g]);
    for (int idx = tid; idx < 17 * 64; idx += 512) { const int j = idx >> 6, p = idx & 63; const float ar = are_[g * 64 + p], ai = aim_[g * 64 + p];
        const float mag = expf(ar * dtf * (float)j); double ang = (double)ai * (double)dtf * (double)j; ang -= 6.283185307179586 * rint(ang * 0.15915494309189535);
        const float af = (float)ang; lbp[idx * 2] = mag * cosf(af); lbp[idx * 2 + 1] = mag * sinf(af); }
    for (int i = tid; i < 1024; i += 512) { Cc[i * 2] = cre_[g * 1024 + i]; Cc[i * 2 + 1] = cim_[g * 1024 + i]; }
    __syncthreads();
    for (int idx = tid; idx < 1024; idx += 512) { const int p = idx >> 4, c = idx & 15; const float ar = are_[g * 64 + p], ai = aim_[g * 64 + p], lr = lbp[(64 + p) * 2], li = lbp[(64 + p) * 2 + 1];
        const float den = ar * ar + ai * ai, nre = lr - 1.0f; const float fre = (nre * ar + li * ai) / den, fim = (li * ar - nre * ai) / den;
        const float br = bre_[(g * 64 + p) * 16 + c], bi = bim_[(g * 64 + p) * 16 + c];
        Bb[idx * 2] = fre * br - fim * bi; Bb[idx * 2 + 1] = fre * bi + fim * br; }
    __syncthreads();
    if (part == 0) {
        if (tid < 128) { const int p = tid & 63, im = tid >> 6; SF[SF_LBL + g * 128 + im * 64 + p] = lbp[(16 * 64 + p) * 2 + im]; SF[SF_LB1 + g * 128 + im * 64 + p] = lbp[(1 * 64 + p) * 2 + im]; }
        for (int i = tid; i < 2048; i += 512) SF[SF_BB + g * 2048 + i] = Bb[i];
    }
    const int j0 = 2 * part;
    { const int e = tid, j = j0 + (e >> 8), c = (e >> 4) & 15, c2 = e & 15; float s = 0.f;
      for (int p = 0; p < 64; ++p) { const float cr = Cc[(c * 64 + p) * 2], ci = Cc[(c * 64 + p) * 2 + 1], lr = lbp[(j * 64 + p) * 2], li = lbp[(j * 64 + p) * 2 + 1];
          const float xr = cr * lr - ci * li, xi = cr * li + ci * lr; s += xr * Bb[(p * 16 + c2) * 2] - xi * Bb[(p * 16 + c2) * 2 + 1]; }
      if (j == 0 && c == c2) s += dd_[g * 16 + c];
      Kt[e] = s; }
    __syncthreads();
    bf16* tq = TQ + (size_t)g * 256 * 384;
    for (int jj = 0; jj < 2; ++jj) { const int j = j0 + jj; const int n = (16 - j) * 256;
        for (int idx = tid; idx < n; idx += 512) { const int t = j + (idx >> 8), c = (idx >> 4) & 15, c2 = idx & 15;
            tq[(size_t)(t * 16 + c) * 384 + (t - j) * 16 + c2] = (bf16)f2bf(Kt[jj * 256 + c * 16 + c2]); } }
    for (int idx = part * 32 * 384 + tid; idx < (part + 1) * 32 * 384; idx += 512) {
        const int row = idx / 384, k = idx - row * 384, t = row >> 4, c = row & 15;
        if (k < 256) { if ((k >> 4) > t) tq[idx] = 0; }
        else { const int q = k - 256, p = q & 63, im = q >> 6; const float cr = Cc[(c * 64 + p) * 2], ci = Cc[(c * 64 + p) * 2 + 1], lr = lbp[((t + 1) * 64 + p) * 2], li = lbp[((t + 1) * 64 + p) * 2 + 1];
            tq[idx] = (bf16)f2bf(im ? -(cr * li + ci * lr) : (cr * lr - ci * li)); }
    }
    bf16* pm = PM + (size_t)g * 128 * 256;
    for (int idx = part * 16 * 256 + tid; idx < (part + 1) * 16 * 256; idx += 512) {
        const int pr = idx >> 8, k = idx & 255, p = pr & 63, im = pr >> 6, s = k >> 4, c2 = k & 15;
        const float lr = lbp[((15 - s) * 64 + p) * 2], li = lbp[((15 - s) * 64 + p) * 2 + 1], br = Bb[(p * 16 + c2) * 2], bi = Bb[(p * 16 + c2) * 2 + 1];
        pm[idx] = (bf16)f2bf(im ? (lr * bi + li * br) : (lr * br - li * bi));
    }
    __syncthreads();
}
#ifndef DBG_KV
#define DBG_KV 1.0f
#endif
#ifndef DBG_MKV
#define DBG_MKV 1.0f
#endif
namespace ep {
using pg8::Unit; using pg8::cvt_pk_bf16;
__device__ __forceinline__ u32x4 pack8(const f32x4 a, const f32x4 b) { u32x4 w; w.x = cvt_pk_bf16(a[0], a[1]); w.y = cvt_pk_bf16(a[2], a[3]); w.z = cvt_pk_bf16(b[0], b[1]); w.w = cvt_pk_bf16(b[2], b[3]); return w; }
__device__ __forceinline__ float sq4(const f32x4 x) { return (x[0] * x[0] + x[1] * x[1]) + (x[2] * x[2] + x[3] * x[3]); }
__device__ __forceinline__ void wave_row_ss(const f32x4 (&acc)[2][2][4][2], float (&ss)[2][4]) {
#pragma unroll
    for (int ai = 0; ai < 2; ++ai)
#pragma unroll
        for (int m = 0; m < 4; ++m) { float s = (sq4(acc[ai][0][m][0]) + sq4(acc[ai][0][m][1])) + (sq4(acc[ai][1][m][0]) + sq4(acc[ai][1][m][1]));
            s += __shfl_xor(s, 16); s += __shfl_xor(s, 32); ss[ai][m] = s; }
}
__device__ __forceinline__ void tile_row_ss(const f32x4 (&acc)[2][2][4][2], LAS float* scr, int wr, int wc, int fr, int fq, float (&ss)[2][4]) {
    wave_row_ss(acc, ss);
    if (fq == 0) {
#pragma unroll
        for (int ai = 0; ai < 2; ++ai)
#pragma unroll
            for (int m = 0; m < 4; ++m) scr[(128 * ai + 64 * wr + 16 * m + fr) * 4 + wc] = ss[ai][m];
    }
    asm volatile("s_waitcnt lgkmcnt(0)" ::: "memory"); __builtin_amdgcn_s_barrier(); asm volatile("" ::: "memory");
#pragma unroll
    for (int ai = 0; ai < 2; ++ai)
#pragma unroll
        for (int m = 0; m < 4; ++m) { const f32x4 t = *(const LAS f32x4*)(scr + (128 * ai + 64 * wr + 16 * m + fr) * 4); ss[ai][m] = (t[0] + t[1]) + (t[2] + t[3]); }
}

struct EpiIn {
    static constexpr bool PERM = true, AFTER_DRAIN = false;
    bf16 *UG, *Qb, *Kb, *Vb; float* out; const float *qg, *kg;
    __device__ __forceinline__ void operator()(const f32x4 (&acc)[2][2][4][2], const Unit& u, int wr, int wc, int fr, int fq) const {
        const int pn = u.pn, row0 = u.pm * 256 + wr * 64 + fr, cw = 64 * wc + 8 * fq;
        if (pn < 2) {
#pragma unroll
            for (int ai = 0; ai < 2; ++ai)
#pragma unroll
                for (int m = 0; m < 4; ++m) { const int r = row0 + 128 * ai + 16 * m;
#pragma unroll
                    for (int bj = 0; bj < 2; ++bj) { const int ch = 256 * pn + cw + 32 * bj;
                        *(u32x4*)(UG + ((size_t)(ch >> 4) * MTOT + r) * 16 + (ch & 15)) = pack8(acc[ai][bj][m][0], acc[ai][bj][m][1]); } }
        } else if (pn < 6) {
            const bool isq = pn < 4; const float* g = isq ? qg : kg; const float sc = isq ? C2 : 1.f;
            f32x4 gv[2][2];
#pragma unroll
            for (int bj = 0; bj < 2; ++bj)
#pragma unroll
                for (int n = 0; n < 2; ++n) gv[bj][n] = *(const f32x4*)(g + 32 * bj + 8 * fq + 4 * n) * sc;
            float ss[2][4]; wave_row_ss(acc, ss);
            const int c0 = (isq ? (pn - 2) : (pn - 4)) * 256 + cw;
            bf16* B = isq ? Qb : Kb;
            float* kout = (u.pm < MP / 256) ? out + O_KP : out + O_KS - (size_t)MP * 512;
#pragma unroll
            for (int ai = 0; ai < 2; ++ai)
#pragma unroll
                for (int m = 0; m < 4; ++m) { const int r = row0 + 128 * ai + 16 * m; const float rinv = 1.f / sqrtf(ss[ai][m] * (1.f / 64.f) + EPS);
#pragma unroll
                    for (int bj = 0; bj < 2; ++bj) { const f32x4 v0 = acc[ai][bj][m][0] * rinv * gv[bj][0], v1 = acc[ai][bj][m][1] * rinv * gv[bj][1];
                        *(u32x4*)(B + (size_t)r * 512 + c0 + 32 * bj) = pack8(v0, v1);
                        if (!isq) { float* o = kout + (size_t)r * 512 + c0 + 32 * bj; *(f32x4*)o = v0 * DBG_KV; *(f32x4*)(o + 4) = v1 * DBG_KV; } } }
        } else {
            const int c0 = (pn - 6) * 256 + cw;
            float* vout = (u.pm < MP / 256) ? out + O_VP : out + O_VS - (size_t)MP * 512;
#pragma unroll
            for (int ai = 0; ai < 2; ++ai)
#pragma unroll
                for (int m = 0; m < 4; ++m) { const int r = row0 + 128 * ai + 16 * m;
#pragma unroll
                    for (int bj = 0; bj < 2; ++bj) { const f32x4 v0 = acc[ai][bj][m][0], v1 = acc[ai][bj][m][1];
                        *(u32x4*)(Vb + (size_t)r * 512 + c0 + 32 * bj) = pack8(v0, v1);
                        float* o = vout + (size_t)r * 512 + c0 + 32 * bj; *(f32x4*)o = v0 * DBG_KV; *(f32x4*)(o + 4) = v1 * DBG_KV; } }
        }
    }
};
struct EpiMemKV {
    static constexpr bool PERM = true, AFTER_DRAIN = false;
    float* out; bf16 *MKb, *MVb; const float* kg; LAS float* scr;
    __device__ __forceinline__ void operator()(const f32x4 (&acc)[2][2][4][2], const Unit& u, int wr, int wc, int fr, int fq) const {
        const int pn = u.pn, row0 = u.pm * 256 + wr * 64 + fr, cw = 64 * wc + 8 * fq;
        const bool isk = pn < 4; const int c0 = (pn & 3) * 256 + cw;
        float ss[2][4];
        f32x4 gv[2][2];
        if (isk) { tile_row_ss(acc, scr, wr, wc, fr, fq, ss);
#pragma unroll
            for (int bj = 0; bj < 2; ++bj)
#pragma unroll
                for (int n = 0; n < 2; ++n) gv[bj][n] = *(const f32x4*)(kg + cw + 32 * bj + 4 * n); }
        float* o32 = out + (isk ? O_MK : O_MV); bf16* ob = isk ? MKb : MVb;
#pragma unroll
        for (int ai = 0; ai < 2; ++ai)
#pragma unroll
            for (int m = 0; m < 4; ++m) { const int r = row0 + 128 * ai + 16 * m; const float rinv = isk ? 1.f / sqrtf(ss[ai][m] * (1.f / 256.f) + EPS) : 1.f;
#pragma unroll
                for (int bj = 0; bj < 2; ++bj) { f32x4 v0 = acc[ai][bj][m][0], v1 = acc[ai][bj][m][1];
                    if (isk) { v0 = v0 * rinv * gv[bj][0]; v1 = v1 * rinv * gv[bj][1]; }
                    *(u32x4*)(ob + (size_t)r * 1024 + c0 + 32 * bj) = pack8(v0, v1);
                    float* o = o32 + (size_t)r * 1024 + c0 + 32 * bj; *(f32x4*)o = v0 * DBG_MKV; *(f32x4*)(o + 4) = v1 * DBG_MKV; } }
    }
};
}
namespace ep {
__device__ __forceinline__ float row_rs(const float* SS, int r) {
    const f32x4* p = (const f32x4*)(SS + (size_t)r * 16); const f32x4 a = p[0], b = p[1], c = p[2], d = p[3];
    const float s = ((a[0] + a[1]) + (a[2] + a[3])) + ((b[0] + b[1]) + (b[2] + b[3])) + ((c[0] + c[1]) + (c[2] + c[3])) + ((d[0] + d[1]) + (d[2] + d[3]));
    return 1.f / sqrtf(s * (1.f / DMODEL) + EPS);
}
__device__ __forceinline__ void tile_rs(const float* SS, int pm, LAS float* rsl) {
    const int tid = threadIdx.x;
    if (tid < 256) rsl[tid] = row_rs(SS, pm * 256 + tid);
    asm volatile("s_waitcnt lgkmcnt(0)" ::: "memory"); __builtin_amdgcn_s_barrier(); asm volatile("" ::: "memory");
}
__device__ __forceinline__ float sigm(float x) { return 1.f / (1.f + __builtin_amdgcn_exp2f(-LOG2E * x)); }
__device__ __forceinline__ f32x4 ld4bf(const bf16* p) { const u32x2 w = *(const u32x2*)p; return (f32x4){bflo(w.x), bfhi(w.x), bflo(w.y), bfhi(w.y)}; }
#define EP_ROWS(...) _Pragma("unroll") for (int ai = 0; ai < 2; ++ai) _Pragma("unroll") for (int m = 0; m < 4; ++m) { const int r = row0 + 128 * ai + 16 * m; __VA_ARGS__ }
struct EpiGlu {
    static constexpr bool PERM = true, AFTER_DRAIN = false;
    const bf16* Gb; bf16* MIX;
    __device__ __forceinline__ void operator()(const f32x4 (&acc)[2][2][4][2], const Unit& u, int wr, int wc, int fr, int fq) const {
        const int row0 = u.pm * 256 + wr * 64 + fr, c0 = u.pn * 256 + 64 * wc + 8 * fq;
        EP_ROWS(
_Pragma("unroll")
            for (int bj = 0; bj < 2; ++bj) { const int c = c0 + 32 * bj; const f32x4 g0 = ld4bf(Gb + (size_t)r * 512 + c), g1 = ld4bf(Gb + (size_t)r * 512 + c + 4);
                f32x4 v0, v1;
_Pragma("unroll")
                for (int j = 0; j < 4; ++j) { v0[j] = g0[j] * sigm(acc[ai][bj][m][0][j]); v1[j] = g1[j] * sigm(acc[ai][bj][m][1][j]); }
                *(u32x4*)(MIX + (size_t)r * 1024 + c) = pack8(v0, v1); } )
    }
};
template <bool RES_BF16> struct EpiRes {
    static constexpr bool PERM = true, AFTER_DRAIN = false;
    const void* resP;
    bf16* XB; float* SS;
    __device__ __forceinline__ void operator()(const f32x4 (&acc)[2][2][4][2], const Unit& u, int wr, int wc, int fr, int fq) const {
        const int row0 = u.pm * 256 + wr * 64 + fr, c0 = u.pn * 256 + 64 * wc + 8 * fq;
_Pragma("unroll")
        for (int ai = 0; ai < 2; ++ai) {
            u32x4 rb[4][2]; f32x4 rf[4][2][2];
_Pragma("unroll")
            for (int m = 0; m < 4; ++m)
_Pragma("unroll")
                for (int bj = 0; bj < 2; ++bj) { const size_t off = (size_t)(row0 + 128 * ai + 16 * m) * DMODEL + c0 + 32 * bj;
                    if (RES_BF16) rb[m][bj] = *(const u32x4*)((const bf16*)resP + off);
                    else { rf[m][bj][0] = *(const f32x4*)((const float*)resP + off); rf[m][bj][1] = *(const f32x4*)((const float*)resP + off + 4); } }
            asm volatile("" ::: "memory");
_Pragma("unroll")
            for (int m = 0; m < 4; ++m) { const int r = row0 + 128 * ai + 16 * m; float s = 0.f;
_Pragma("unroll")
                for (int bj = 0; bj < 2; ++bj) { const size_t off = (size_t)r * DMODEL + c0 + 32 * bj; f32x4 x0, x1;
                    if (RES_BF16) { const u32x4 w = rb[m][bj]; x0 = (f32x4){bflo(w.x), bfhi(w.x), bflo(w.y), bfhi(w.y)}; x1 = (f32x4){bflo(w.z), bfhi(w.z), bflo(w.w), bfhi(w.w)}; }
                    else { x0 = rf[m][bj][0]; x1 = rf[m][bj][1]; }
                    x0 += acc[ai][bj][m][0]; x1 += acc[ai][bj][m][1]; s += sq4(x0) + sq4(x1);
                    *(u32x4*)(XB + off) = pack8(x0, x1); }
                s += __shfl_xor(s, 16); s += __shfl_xor(s, 32);
                if (fq == 0) SS[(size_t)r * 16 + 4 * u.pn + wc] = s; }
        }
    }
};
struct EpiCq {
    static constexpr bool PERM = true, AFTER_DRAIN = false;
    const float* SS; bf16* CQ; const float* gq; LAS float* scr; LAS float* rsl;
    __device__ __forceinline__ void operator()(const f32x4 (&acc)[2][2][4][2], const Unit& u, int wr, int wc, int fr, int fq) const {
        const int row0 = u.pm * 256 + wr * 64 + fr, cw = 64 * wc + 8 * fq, c0 = u.pn * 256 + cw;
        tile_rs(SS, u.pm, rsl);
        float ss[2][4]; tile_row_ss(acc, scr, wr, wc, fr, fq, ss);
        f32x4 gv[2][2];
_Pragma("unroll")
        for (int bj = 0; bj < 2; ++bj)
_Pragma("unroll")
            for (int n = 0; n < 2; ++n) gv[bj][n] = *(const f32x4*)(gq + cw + 32 * bj + 4 * n) * CA2;
        EP_ROWS( const float rs = rsl[r & 255]; const float sc = rs / sqrtf(rs * rs * ss[ai][m] * (1.f / 256.f) + EPS);
_Pragma("unroll")
            for (int bj = 0; bj < 2; ++bj) *(u32x4*)(CQ + (size_t)r * 1024 + c0 + 32 * bj) = pack8(acc[ai][bj][m][0] * sc * gv[bj][0], acc[ai][bj][m][1] * sc * gv[bj][1]); )
    }
};
#ifndef FFN_ROR_FLIP
#define FFN_ROR_FLIP 0
#endif
template <int N> __device__ __forceinline__ float row_from_below(float v) {
    return __builtin_bit_cast(float, __builtin_amdgcn_update_dpp(0, __builtin_bit_cast(int, v), 0x120 + (FFN_ROR_FLIP ? 16 - N : N), 0xf, 0xf, false));
}
struct RunOrder {
    int pn, pm0, len;
    __device__ __forceinline__ void init(int run) { pn = run / 11; const int k = run - pn * 11; len = k < 9 ? 6 : 5; pm0 = k < 9 ? 6 * k : 54 + 5 * (k - 9); }
    __device__ __forceinline__ bool next(int i, Unit& u) const { if (i >= len) return false; u.pm = pm0 + i; u.pn = pn; return true; }
    __device__ __forceinline__ void a_ready(const Unit&) const {}
    __device__ __forceinline__ void done(const Unit&) const {}
};
constexpr int FFN_RUNS = 22 * 11;
__device__ __forceinline__ int halo_idx(int slot, int wc, int row, int ci) { return ((slot * 4 + wc) * 2 + row) * 32 + ci; }
__device__ __forceinline__ void ffn_carry_init(const bf16* XB2, const bf16* WGV, const float* SS, int pm0, int pn, LAS float* hal, int tid) {
    const int ch = tid >> 2, kq = tid & 3, slot = 4 + (pm0 & 1);
    float d0 = 0.f, d1 = 0.f;
    if ((pm0 & 15) != 0) {
        const bf16* wrow = WGV + (size_t)(256 * pn + ch) * DMODEL + 256 * kq; const bf16* x0 = XB2 + (size_t)(256 * pm0 - 2) * DMODEL + 256 * kq; const bf16* x1 = x0 + DMODEL;
#pragma unroll 4
        for (int i = 0; i < 32; ++i) { const u32x4 w = *(const u32x4*)(wrow + 8 * i), a = *(const u32x4*)(x0 + 8 * i), b = *(const u32x4*)(x1 + 8 * i);
#pragma unroll
            for (int q = 0; q < 4; ++q) { d0 += bflo(w[q]) * bflo(a[q]) + bfhi(w[q]) * bfhi(a[q]); d1 += bflo(w[q]) * bflo(b[q]) + bfhi(w[q]) * bfhi(b[q]); } }
        d0 = quad_allsum(d0); d1 = quad_allsum(d1);
        d0 *= row_rs(SS, 256 * pm0 - 2); d1 *= row_rs(SS, 256 * pm0 - 1);
    }
    if (kq == 0) { hal[halo_idx(slot, ch >> 5, 0, ch & 31)] = d0; hal[halo_idx(slot, ch >> 5, 1, ch & 31)] = d1; }
    __syncthreads();
}
struct EpiFfn {
    static constexpr bool PERM = true, AFTER_DRAIN = false;
    const float* SS; bf16* H; float* out; const float* cw_; const float* cb_; LAS float* rsl; LAS float* hal;
    __device__ __forceinline__ void operator()(const f32x4 (&acc)[2][2][4][2], const Unit& u, int wr, int wc, int fr, int fq) const {
        const int row0 = u.pm * 256 + wr * 64 + fr, ci0 = 8 * fq, ch0 = u.pn * 128 + 32 * wc + ci0;
        tile_rs(SS, u.pm, rsl);
        f32x4 gs[2][4][2];
_Pragma("unroll")
        for (int ai = 0; ai < 2; ++ai)
_Pragma("unroll")
            for (int m = 0; m < 4; ++m) { const float rs = rsl[128 * ai + 64 * wr + 16 * m + fr]; gs[ai][m][0] = acc[ai][0][m][0] * rs; gs[ai][m][1] = acc[ai][0][m][1] * rs; }
        if (fr >= 14) {
            const bool seq_end = (u.pm & 15) == 15;
_Pragma("unroll")
            for (int ai = 0; ai < 2; ++ai) { const int q = 2 * ai + wr + 1; const int slot = q < 4 ? q : 4 + ((u.pm + 1) & 1); const bool zero = (q == 4) && seq_end;
_Pragma("unroll")
                for (int n = 0; n < 2; ++n) *(LAS f32x4*)(hal + halo_idx(slot, wc, fr - 14, ci0 + 4 * n)) = zero ? (f32x4){0.f, 0.f, 0.f, 0.f} : gs[ai][3][n];
                if (seq_end && ai == 1 && wr == 1) {
                    float* co = out + O_CP + (size_t)((u.pm >> 4) * 2 + (fr - 14)) * FF + ch0; *(f32x4*)co = gs[1][3][0]; *(f32x4*)(co + 4) = gs[1][3][1]; } }
        }
        asm volatile("s_waitcnt lgkmcnt(0)" ::: "memory"); __builtin_amdgcn_s_barrier(); asm volatile("" ::: "memory");
        f32x4 w0[2], w1[2], w2[2], bb[2];
_Pragma("unroll")
        for (int n = 0; n < 2; ++n) { w0[n] = *(const f32x4*)(cw_ + ch0 + 4 * n); w1[n] = *(const f32x4*)(cw_ + FF + ch0 + 4 * n); w2[n] = *(const f32x4*)(cw_ + 2 * FF + ch0 + 4 * n); bb[n] = *(const f32x4*)(cb_ + ch0 + 4 * n); }
_Pragma("unroll")
        for (int ai = 0; ai < 2; ++ai)
_Pragma("unroll")
            for (int m = 0; m < 4; ++m) { const int r = row0 + 128 * ai + 16 * m; const float rs = rsl[128 * ai + 64 * wr + 16 * m + fr]; f32x4 o[2];
_Pragma("unroll")
                for (int n = 0; n < 2; ++n) { f32x4 p1, p2, q1, q2;
                    if (m > 0) {
_Pragma("unroll")
                        for (int j = 0; j < 4; ++j) { q1[j] = row_from_below<1>(gs[ai][m - 1][n][j]); q2[j] = row_from_below<2>(gs[ai][m - 1][n][j]); } }
                    else { const int slot = (2 * ai + wr) ? (2 * ai + wr) : 4 + (u.pm & 1);
                        q1 = *(const LAS f32x4*)(hal + halo_idx(slot, wc, 1, ci0 + 4 * n)); q2 = *(const LAS f32x4*)(hal + halo_idx(slot, wc, fr == 0 ? 0 : 1, ci0 + 4 * n)); }
_Pragma("unroll")
                    for (int j = 0; j < 4; ++j) { p1[j] = row_from_below<1>(gs[ai][m][n][j]); p2[j] = row_from_below<2>(gs[ai][m][n][j]); }
                    const f32x4 h1 = fr >= 1 ? p1 : q1, h0 = fr >= 2 ? p2 : q2;
                    const f32x4 cv = bb[n] + w0[n] * h0 + w1[n] * h1 + w2[n] * gs[ai][m][n];
_Pragma("unroll")
                    for (int j = 0; j < 4; ++j) o[n][j] = cv[j] * sigm(cv[j]) * (acc[ai][1][m][n][j] * rs); }
                *(u32x4*)(H + hidx(r, ch0)) = pack8(o[0], o[1]); }
    }
};
struct EpiOut {
    static constexpr bool PERM = true, AFTER_DRAIN = false;
    const bf16* X2; float* out;
    __device__ __forceinline__ void operator()(const f32x4 (&acc)[2][2][4][2], const Unit& u, int wr, int wc, int fr, int fq) const {
        const int row0 = u.pm * 256 + wr * 64 + fr, c0 = u.pn * 256 + 64 * wc + 8 * fq;
        float* y = (u.pm < MP / 256) ? out + O_YP : out + O_YS - (size_t)MP * DMODEL;
_Pragma("unroll")
        for (int ai = 0; ai < 2; ++ai) { u32x4 rb[4][2];
_Pragma("unroll")
            for (int m = 0; m < 4; ++m)
_Pragma("unroll")
                for (int bj = 0; bj < 2; ++bj) rb[m][bj] = *(const u32x4*)(X2 + (size_t)(row0 + 128 * ai + 16 * m) * DMODEL + c0 + 32 * bj);
            asm volatile("" ::: "memory");
_Pragma("unroll")
            for (int m = 0; m < 4; ++m)
_Pragma("unroll")
                for (int bj = 0; bj < 2; ++bj) { const size_t off = (size_t)(row0 + 128 * ai + 16 * m) * DMODEL + c0 + 32 * bj; const u32x4 w = rb[m][bj];
                    const f32x4 x0 = (f32x4){bflo(w.x), bfhi(w.x), bflo(w.y), bfhi(w.y)}, x1 = (f32x4){bflo(w.z), bfhi(w.z), bflo(w.w), bfhi(w.w)};
                    *(f32x4*)(y + off) = x0 + acc[ai][bj][m][0]; *(f32x4*)(y + off + 4) = x1 + acc[ai][bj][m][1]; } }
    }
};
}
__device__ __forceinline__ float gelu_tanh(float x) {
    const float z = 0.7978845608028654f * (x + 0.044715f * x * x * x);
    return x / (1.f + __builtin_amdgcn_exp2f(-2.f * LOG2E * z));
}
constexpr int SSM_E_PITCH = 132, SSM_S_PITCH = 136;
constexpr int SSM_E_OFF = 0, SSM_S_OFF = 64 * SSM_E_PITCH * 4, SSM_U_OFF = SSM_S_OFF + 64 * SSM_S_PITCH * 2, SSM_U_PITCH = 528;
__device__ __forceinline__ void ssm_prompt_item(const bf16* UG, const bf16* TQ, const bf16* PM, const float* SF, bf16* Gb, float* out, int b, int g, LAS unsigned char* lds, int tid) {
    const int lane = tid & 63, w = __builtin_amdgcn_readfirstlane(tid >> 6), r32 = lane & 31, hi = lane >> 5;
    LAS float* El = (LAS float*)(lds + SSM_E_OFF); LAS bf16* Sl = (LAS bf16*)(lds + SSM_S_OFF); LAS unsigned char* Ul = lds + SSM_U_OFF;
    const bf16* ug = UG + ((size_t)g * MTOT + (size_t)b * SEQ) * 16;
    const bf16* pm = PM + (size_t)g * 128 * 256; const bf16* tq = TQ + (size_t)g * 256 * 384;
    float Sre = 0.f, Sim = 0.f, lr = 0.f, li = 0.f;
    if (w == 0) { lr = SF[SF_LBL + g * 128 + lane]; li = SF[SF_LBL + g * 128 + 64 + lane]; }
    u32x4 ureg[4];
#pragma unroll
    for (int it = 0; it < 4; ++it) ureg[it] = *(const u32x4*)(ug + (size_t)(tid + 512 * it) * 8);
    const int mblk = w & 3, nblk = w >> 2;
    const bf16* apA = pm + (size_t)(32 * mblk + r32) * 256 + 8 * hi; const bf16* apC = tq + (size_t)(32 * w + r32) * 384 + 8 * hi;
    bf16x8 afA[16];
#pragma unroll
    for (int ks = 0; ks < 16; ++ks) afA[ks] = *(const bf16x8*)(apA + 16 * ks);
    for (int sc = 0; sc < 4; ++sc) {
        asm volatile("s_waitcnt vmcnt(0)" ::: "memory");
        __syncthreads();
#pragma unroll
        for (int it = 0; it < 4; ++it) { const int idx = tid + 512 * it; *(LAS u32x4*)(Ul + (idx >> 5) * SSM_U_PITCH + (idx & 31) * 16) = ureg[it]; }
        __syncthreads();
        if (sc < 3) {
#pragma unroll
            for (int it = 0; it < 4; ++it) ureg[it] = *(const u32x4*)(ug + (size_t)(sc + 1) * 64 * 256 + (size_t)(tid + 512 * it) * 8); }
        { f32x16 acc = {};
          const LAS unsigned char* bp = Ul + (32 * nblk + r32) * SSM_U_PITCH + 16 * hi;
#pragma unroll
          for (int ks = 0; ks < 16; ++ks) acc = __builtin_amdgcn_mfma_f32_32x32x16_bf16(afA[ks], *(const LAS bf16x8*)(bp + 32 * ks), acc, 0, 0, 0);
#pragma unroll
          for (int r = 0; r < 16; ++r) El[(32 * nblk + r32) * SSM_E_PITCH + 32 * mblk + (r & 3) + 8 * (r >> 2) + 4 * hi] = acc[r]; }
        bf16x8 afC[24];
#pragma unroll
        for (int ks = 0; ks < 24; ++ks) afC[ks] = *(const bf16x8*)(apC + 16 * ks);
        __syncthreads();
        if (w == 0) {
#pragma unroll 1
            for (int c0 = 0; c0 < 64; c0 += 8) { float er[8], ei[8];
#pragma unroll
                for (int j = 0; j < 8; ++j) { er[j] = El[(c0 + j) * SSM_E_PITCH + lane]; ei[j] = El[(c0 + j) * SSM_E_PITCH + 64 + lane]; }
#pragma unroll
                for (int j = 0; j < 8; ++j) { Sl[(c0 + j) * SSM_S_PITCH + lane] = (bf16)f2bf(Sre); Sl[(c0 + j) * SSM_S_PITCH + 64 + lane] = (bf16)f2bf(Sim);
                    const float nr = lr * Sre - li * Sim + er[j], ni = lr * Sim + li * Sre + ei[j]; Sre = nr; Sim = ni; } }
        }
        __syncthreads();
        { f32x16 acc0 = {}, acc1 = {};
          const LAS unsigned char* bp0 = Ul + r32 * SSM_U_PITCH + 16 * hi; const LAS unsigned char* bp1 = bp0 + 32 * SSM_U_PITCH;
          asm volatile("s_waitcnt vmcnt(0)" ::: "memory");
#pragma unroll
          for (int ks = 0; ks < 16; ++ks) { acc0 = __builtin_amdgcn_mfma_f32_32x32x16_bf16(afC[ks], *(const LAS bf16x8*)(bp0 + 32 * ks), acc0, 0, 0, 0);
              acc1 = __builtin_amdgcn_mfma_f32_32x32x16_bf16(afC[ks], *(const LAS bf16x8*)(bp1 + 32 * ks), acc1, 0, 0, 0); }
#pragma unroll
          for (int ks = 0; ks < 8; ++ks) {
              const bf16x8 b0 = *(const LAS bf16x8*)(Sl + r32 * SSM_S_PITCH + 16 * ks + 8 * hi), b1 = *(const LAS bf16x8*)(Sl + (32 + r32) * SSM_S_PITCH + 16 * ks + 8 * hi);
              acc0 = __builtin_amdgcn_mfma_f32_32x32x16_bf16(afC[16 + ks], b0, acc0, 0, 0, 0); acc1 = __builtin_amdgcn_mfma_f32_32x32x16_bf16(afC[16 + ks], b1, acc1, 0, 0, 0); }
          if (sc < 3) {
#pragma unroll
              for (int ks = 0; ks < 16; ++ks) afA[ks] = *(const bf16x8*)(apA + 16 * ks); }
          const size_t tok0 = (size_t)b * SEQ + (size_t)sc * 1024;
#pragma unroll
          for (int nb = 0; nb < 2; ++nb)
#pragma unroll
              for (int q = 0; q < 4; ++q) { const f32x16& A = nb ? acc1 : acc0; const int t = 2 * w + (q >> 1), c0 = 8 * (q & 1) + 4 * hi; const size_t tok = tok0 + (size_t)(32 * nb + r32) * 16 + t;
                  u32x2 o; o.x = pk2(gelu_tanh(A[4 * q]), gelu_tanh(A[4 * q + 1])); o.y = pk2(gelu_tanh(A[4 * q + 2]), gelu_tanh(A[4 * q + 3]));
                  *(u32x2*)(Gb + tok * 512 + 16 * g + c0) = o; } }
    }
    if (w == 0) { out[O_HRP + (b * NG + g) * 64 + lane] = Sre * DBG_SSM; out[O_HIP + (b * NG + g) * 64 + lane] = Sim * DBG_SSM; }
    __syncthreads();
}
__device__ __forceinline__ void ssm_sample_item(const bf16* UG, const float* SF, const float* cre, const float* cim, const float* dd, const float* sre, const float* sim,
                                                bf16* Gb, float* out, int s, int g, LAS float* hs, const LAS float* Cl, int lane) {
    float Sre = sre[(s * NG + g) * 64 + lane], Sim = sim[(s * NG + g) * 64 + lane];
    const float lr = SF[SF_LB1 + g * 128 + lane], li = SF[SF_LB1 + g * 128 + 64 + lane];
    f32x4 bb[8];
#pragma unroll
    for (int i = 0; i < 8; ++i) bb[i] = *(const f32x4*)(SF + SF_BB + g * 2048 + lane * 32 + 4 * i);
    const bf16* up = UG + ((size_t)g * MTOT + MP + 4 * s) * 16;
    u32x4 uw[8];
#pragma unroll
    for (int i = 0; i < 8; ++i) uw[i] = *(const u32x4*)(up + 8 * i);
    const float uval = bf2f(up[lane]), dval = dd[g * 16 + (lane & 15)];
#pragma unroll
    for (int t = 0; t < 4; ++t) { float br = 0.f, bi = 0.f;
#pragma unroll
        for (int c = 0; c < 16; ++c) { const unsigned wd = uw[2 * t + (c >> 3)][(c & 7) >> 1]; const float u = (c & 1) ? bfhi(wd) : bflo(wd);
            br += bb[c >> 1][2 * (c & 1)] * u; bi += bb[c >> 1][2 * (c & 1) + 1] * u; }
        const float nr = lr * Sre - li * Sim + br, ni = lr * Sim + li * Sre + bi; Sre = nr; Sim = ni;
        hs[t * 128 + lane] = Sre; hs[t * 128 + 64 + lane] = Sim; }
    out[O_HRS + (size_t)(s * NG + g) * 64 + lane] = Sre * DBG_SSM; out[O_HIS + (size_t)(s * NG + g) * 64 + lane] = Sim * DBG_SSM;
    LDS_WAIT(); asm volatile("" ::: "memory");
    const int t = lane >> 4, c = lane & 15; float y = 0.f;
#pragma unroll
    for (int p4 = 0; p4 < 16; ++p4) { const f32x4 a = *(const LAS f32x4*)(Cl + c * 68 + 4 * p4), bq = *(const LAS f32x4*)(Cl + 16 * 68 + c * 68 + 4 * p4);
        const f32x4 hr = *(const LAS f32x4*)(hs + t * 128 + 4 * p4), hq = *(const LAS f32x4*)(hs + t * 128 + 64 + 4 * p4);
        y += (a[0] * hr[0] - bq[0] * hq[0]) + (a[1] * hr[1] - bq[1] * hq[1]) + (a[2] * hr[2] - bq[2] * hq[2]) + (a[3] * hr[3] - bq[3] * hq[3]); }
    y += dval * uval;
    Gb[(size_t)(MP + 4 * s + t) * 512 + 16 * g + c] = (bf16)f2bf(gelu_tanh(y));
    LDS_WAIT(); asm volatile("" ::: "memory");
}
namespace attn_body {
using bf16=__hip_bfloat16;
using s16x4=__attribute__((ext_vector_type(4)))short;
constexpr int SEQ=4096,D=64,DM=512;
constexpr int NW=8,QBLK=32,QB=QBLK*NW,KVBLK=64,NQB=SEQ/QB;
constexpr int ATTN_PITCH=DM, ATTN_UNIT_ROWS=QB;
__device__ __forceinline__ int crow(int r,int hi){return (r&3)+8*(r>>2)+4*hi;}
#define SBAR() __builtin_amdgcn_sched_barrier(0)
__device__ __forceinline__ void cmask(f32x16&p0,f32x16&p1,int jb,int qrel,int hi){
  const float NEG=-INFINITY; int kb=64*jb+4*hi;
  #pragma unroll
  for(int r=0;r<16;++r){int kv=kb+(r&3)+8*(r>>2); if(kv>qrel)p0[r]=NEG; if(kv+32>qrel)p1[r]=NEG;}
}

constexpr int NSLOT=3, SLOTB=8192;
constexpr int LDS_K=0, LDS_V=NSLOT*SLOTB, LDS_WS=2*NSLOT*SLOTB, LDS_OST=LDS_WS+NW*64*4, LDS_BYTES=LDS_OST+NW*4096;
constexpr float C2=0.125f*1.4426950408889634f;
__device__ __forceinline__ void glds16(const void*gsrc,unsigned lds_dst){unsigned keep;
  asm volatile("s_mov_b32 %0, m0\n\ts_mov_b32 m0, %2\n\ts_nop 0\n\tglobal_load_lds_dwordx4 %1, off\n\ts_mov_b32 m0, %0":"=&s"(keep):"v"(gsrc),"s"(lds_dst):"memory");}
__device__ __forceinline__ float max3f(float a,float b,float c){float r;asm("v_max3_f32 %0, %1, %2, %3":"=v"(r):"v"(a),"v"(b),"v"(c));return r;}
__device__ __forceinline__ float max2f(float a,float b){float r;asm("v_max_f32_e32 %0, %1, %2":"=v"(r):"v"(a),"v"(b));return r;}
__device__ __forceinline__ float fadd_s(float a,float b){float r;asm("v_add_f32_e32 %0, %1, %2":"=v"(r):"v"(a),"v"(b));return r;}
__device__ __forceinline__ float fsub_s(float a,float b){float r;asm("v_sub_f32_e32 %0, %1, %2":"=v"(r):"v"(a),"v"(b));return r;}
typedef float f32x2_t __attribute__((ext_vector_type(2))); typedef __bf16 bf16x2_t __attribute__((ext_vector_type(2)));
__device__ __forceinline__ unsigned cvtpk_s(float lo,float hi){f32x2_t v={lo,hi};bf16x2_t b=__builtin_convertvector(v,bf16x2_t);return __builtin_bit_cast(unsigned,b);}
#define WAIT_BAR(N) asm volatile("s_waitcnt vmcnt(" #N ") lgkmcnt(0)\n\ts_barrier":::"memory")

__device__ __forceinline__ void qkt(f32x16&p0,f32x16&p1,const char*Kslot,const bf16x8*qr,const f32x16&negm,int r32,int hi){
  const char*kb=Kslot+hi*1024+r32*16;
  #pragma unroll
  for(int d0=0;d0<4;++d0){
    const bf16x8 b0=*reinterpret_cast<const bf16x8*>(kb+d0*2048);
    const bf16x8 b1=*reinterpret_cast<const bf16x8*>(kb+d0*2048+512);
    if(d0==0){p0=__builtin_amdgcn_mfma_f32_32x32x16_bf16(b0,qr[0],negm,0,0,0);p1=__builtin_amdgcn_mfma_f32_32x32x16_bf16(b1,qr[0],negm,0,0,0);}
    else{p0=__builtin_amdgcn_mfma_f32_32x32x16_bf16(b0,qr[d0],p0,0,0,0);p1=__builtin_amdgcn_mfma_f32_32x32x16_bf16(b1,qr[d0],p1,0,0,0);}}
}
typedef __attribute__((address_space(3))) const char* lds_cptr;
typedef short v4i16_t __attribute__((ext_vector_type(4)));
__device__ __forceinline__ void kload8(bf16x8*kf,lds_cptr kp){
  kf[0]=*(const __attribute__((address_space(3))) bf16x8*)(kp);      kf[1]=*(const __attribute__((address_space(3))) bf16x8*)(kp+512);
  kf[2]=*(const __attribute__((address_space(3))) bf16x8*)(kp+2048); kf[3]=*(const __attribute__((address_space(3))) bf16x8*)(kp+2560);
  kf[4]=*(const __attribute__((address_space(3))) bf16x8*)(kp+4096); kf[5]=*(const __attribute__((address_space(3))) bf16x8*)(kp+4608);
  kf[6]=*(const __attribute__((address_space(3))) bf16x8*)(kp+6144); kf[7]=*(const __attribute__((address_space(3))) bf16x8*)(kp+6656);
}
__device__ __forceinline__ void kload2(bf16x8*kf,lds_cptr kp,int j){ kf[2*j]=*(const __attribute__((address_space(3))) bf16x8*)(kp+j*2048); kf[2*j+1]=*(const __attribute__((address_space(3))) bf16x8*)(kp+j*2048+512); }
__device__ __forceinline__ s16x4 vtr(lds_cptr p){ return __builtin_bit_cast(s16x4,__builtin_amdgcn_ds_read_tr16_b64_v4i16((__attribute__((address_space(3))) v4i16_t*)p)); }
__device__ __forceinline__ float rowmax(const f32x16&p0,const f32x16&p1){
  float a=max3f(p0[0],p0[1],p1[0]),b=max3f(p0[2],p0[3],p1[1]);a=max3f(a,p1[2],p1[3]);
  #pragma unroll
  for(int r=4;r<16;r+=4){a=max3f(a,p0[r],p0[r+1]);b=max3f(b,p0[r+2],p0[r+3]);a=max3f(a,p1[r],p1[r+1]);b=max3f(b,p1[r+2],p1[r+3]);}
  const float m=max2f(a,b);
  auto rr=__builtin_amdgcn_permlane32_swap(__float_as_uint(m),__float_as_uint(m),false,false);
  return max2f(__uint_as_float(rr[0]),__uint_as_float(rr[1]));
}
__device__ __forceinline__ void pv(f32x16*o,int vb,bf16x8 pa0,bf16x8 pa1,bf16x8 pa2,bf16x8 pa3){
  #pragma unroll
  for(int d0=0;d0<2;++d0){s16x4 lo[4],hi[4];
    #pragma unroll
    for(int ks=0;ks<4;++ks){
      asm volatile("ds_read_b64_tr_b16 %0,%1 offset:%c2":"=&v"(lo[ks]):"v"(vb),"i"(d0*4096+ks*1024):"memory");
      asm volatile("ds_read_b64_tr_b16 %0,%1 offset:%c2":"=&v"(hi[ks]):"v"(vb),"i"(d0*4096+ks*1024+512):"memory");}
    asm volatile("s_waitcnt lgkmcnt(0)":::"memory");SBAR();
    #define PK(k) (bf16x8){lo[k][0],lo[k][1],lo[k][2],lo[k][3],hi[k][0],hi[k][1],hi[k][2],hi[k][3]}
    o[d0]=__builtin_amdgcn_mfma_f32_32x32x16_bf16(pa0,PK(0),o[d0],0,0,0);
    o[d0]=__builtin_amdgcn_mfma_f32_32x32x16_bf16(pa1,PK(1),o[d0],0,0,0);
    o[d0]=__builtin_amdgcn_mfma_f32_32x32x16_bf16(pa2,PK(2),o[d0],0,0,0);
    o[d0]=__builtin_amdgcn_mfma_f32_32x32x16_bf16(pa3,PK(3),o[d0],0,0,0);
    #undef PK
  }
}

#ifndef ATTN_STORE16
#define ATTN_STORE16(p,v) (*(u32x4*)(p)=(v))
#endif
template<int THRL> __device__ __forceinline__ void attn_unit(int b,int qb,const bf16*Q,const bf16*__restrict__ K,const bf16*__restrict__ V,bf16*O,char*shm,const float a2,const int t0,const float mref,bf16x8(&qr)[4],const bool pre,const bool hasnext,const int qbn,const bf16*Qn,const bf16*Kn,const int t0n){
  int tid_=threadIdx.x; asm volatile("":"+v"(tid_));
  const int tid=tid_,lane=tid&63,r32=lane&31,hi=lane>>5; const int wid=__builtin_amdgcn_readfirstlane(tid>>6);
  const long rowbase=(long)b*SEQ; const int q0=qb*QB;
  const bf16*Qw=Q+(rowbase+q0+wid*QBLK)*DM;
  const bf16*Kh=K+(rowbase+(long)t0*KVBLK)*DM,*Vh=V+(rowbase+(long)t0*KVBLK)*DM;
  const unsigned lds0=(unsigned)(uintptr_t)shm;
  float*wsf=(float*)(shm+LDS_WS)+wid*64;
  const bf16*ksrc=Kh+(long)lane*DM+wid*8;
  const bf16*vsrc=Vh+(long)(16*(wid&3)+(lane>>2))*DM+(wid>>2)*32+(lane&3)*8;
  const unsigned kdst=lds0+LDS_K+wid*1024, vdst=lds0+LDS_V+wid*1024;
  #define DMA_K(t,slot) glds16(ksrc+(long)(t)*KVBLK*DM,(unsigned)__builtin_amdgcn_readfirstlane(kdst+(slot)))
  #define DMA_V(t,slot) glds16(vsrc+(long)(t)*KVBLK*DM,(unsigned)__builtin_amdgcn_readfirstlane(vdst+(slot)))
  const int vb0=(int)(lds0+LDS_V)+((lane>>4)&1)*32+(lane&3)*8+(4*hi+((lane&15)>>2))*64;
  const char*Kbase=shm+LDS_K; bf16x8 kf[8];
  const lds_cptr shm3=(lds_cptr)shm; const lds_cptr kp0=shm3+LDS_K+hi*1024+r32*16; const lds_cptr vp0=shm3+LDS_V+((lane>>4)&1)*32+(lane&3)*8+(4*hi+((lane&15)>>2))*64;
  const int NT=(q0+QB)/KVBLK-t0;
  if(!pre){ DMA_K(0,0);DMA_K(1,SLOTB);DMA_K(2,2*SLOTB); }
  if(!pre){
  #pragma unroll
  for(int d0=0;d0<4;++d0)qr[d0]=*reinterpret_cast<const bf16x8*>(&Qw[(long)r32*DM+d0*16+hi*8]); }
  DMA_V(0,0);
  float l_reg=0.f;f32x16 o[2];o[0]=f32x16{};o[1]=f32x16{};
  float sl; { float hb_=(float)(4*hi-(q0+wid*QBLK+r32-64*t0)); asm volatile("":"+v"(hb_)); sl=a2*hb_-mref; }
  float KR[16];
  _Pragma("unroll") for(int r=0;r<16;++r){ const float kv_=a2*(float)((r&3)+8*(r>>2)); asm volatile("s_nop 1\n\tv_readfirstlane_b32 %0, %1":"=s"(KR[r]):"v"(kv_)); }
  const float a64=64.f*a2,a32=32.f*a2;
  #define SADD(d,s,v) asm("v_add_f32_e32 %0, %1, %2":"=v"(d):"s"(s),"v"(v))
  #define INITC(X0,X1) do{ sl+=a64; const float sl2_=sl+a32; _Pragma("unroll") for(int r=0;r<16;++r){ float x0_,x1_; SADD(x0_,KR[r],sl); SADD(x1_,KR[r],sl2_); X0[r]=x0_; X1[r]=x1_; } asm volatile("":"+v"(X0),"+v"(X1)); }while(0)
  #define ADD32(P1) do{ _Pragma("unroll") for(int r=0;r<16;++r)P1[r]+=a32; }while(0)
  const int qrel=wid*QBLK+r32;
  #define CMASK(P0,P1,t) do{int jb_=(t)-(NT-4); if(jb_>=0)cmask(P0,P1,jb_,qrel,hi);}while(0)
  bool resc=false;
  #define START(P0,P1) do{ _Pragma("unroll") for(int r=0;r<16;++r)P0[r]=__builtin_amdgcn_exp2f(P0[r]); }while(0)
  #define RESC() do{ if(resc){ asm volatile("s_waitcnt lgkmcnt(0)":::"memory"); \
      _Pragma("unroll") for(int d_=0;d_<2;++d_) _Pragma("unroll") for(int r=0;r<16;++r)o[d_][r]*=wsf[crow(r,hi)]; } }while(0)
  f32x16 pA0,pA1,pB0,pB1;
  int sl_prev=0,sl_cur=0,sl_next=SLOTB;
  #define ROT() do{sl_prev=sl_cur;sl_cur=sl_next;sl_next=(sl_next==(NSLOT-1)*SLOTB)?0:sl_next+SLOTB;}while(0)
  WAIT_BAR(1);
  { f32x16 c0_; _Pragma("unroll") for(int r=0;r<16;++r){ float x_; SADD(x_,KR[r],sl); c0_[r]=x_; } asm volatile("s_nop 1":"+v"(c0_));
    qkt(pA0,pA1,Kbase,qr,c0_,r32,hi); }
  asm volatile("s_nop 15\n\ts_nop 7":"+v"(pA0),"+v"(pA1));ADD32(pA1);CMASK(pA0,pA1,0);
  START(pA0,pA1);
  _Pragma("unroll") for(int r=0;r<16;++r)pA1[r]=__builtin_amdgcn_exp2f(pA1[r]);
  WAIT_BAR(0);
  DMA_K(3,0);DMA_V(1,SLOTB);
  ROT();
  kload8(kf,kp0+sl_cur);
  WAIT_BAR(2);
  s16x4 vlo[8],vhi[8]; u32x4 pw0,pw1,pw2,pw3;
  #define PKW(P,B) cvtpk_s(P[B],P[B+1])
  #define PAF(k) __builtin_bit_cast(bf16x8,pw##k)
  #define VFR(i) (bf16x8){vlo[i][0],vlo[i][1],vlo[i][2],vlo[i][3],vhi[i][0],vhi[i][1],vhi[i][2],vhi[i][3]}
  #define PIN(x) asm volatile("":"+v"(x))
  #define MX3(a,b,c) __builtin_fmaxf(__builtin_fmaxf((a),(b)),(c))
  #define GAPA(MF,A0,A1,A2,A3,W0,W1,PW) do{ MF; sacc+=A0; sacc+=A1; sacc+=A2; sacc+=A3; PIN(sacc); W0; W1; PIN(PW); SBAR(); }while(0)
  #define EX(v) __builtin_amdgcn_exp2f(v)
  #define GAPB(MF,X,B) do{ MF; PIN(o[0]); PIN(o[1]); X[B]=EX(X[B]); X[B+1]=EX(X[B+1]); X[B+2]=EX(X[B+2]); X[B+3]=EX(X[B+3]); PIN(X); SBAR(); }while(0)
  #define VRD(i) do{ vlo[i]=vtr(vp_+(((i)>>2)*4096+((i)&3)*1024)); vhi[i]=vtr(vp_+(((i)>>2)*4096+((i)&3)*1024+512)); }while(0)
  #define KRD(G,j) do{ if(G){ kload2(kf,kp0+sl_next,j); SBAR(); } }while(0)
  #define STEP(C0,C1,P0,P1,t,GK,GV,GL) do{ SBAR(); INITC(C0,C1); SBAR(); \
    const lds_cptr vp_=vp0+sl_prev; \
    VRD(0); SBAR(); float sacc=(P0[0]+P0[1]); \
    GAPA(C0=__builtin_amdgcn_mfma_f32_32x32x16_bf16(kf[0],qr[0],C0,0,0,0), P0[2],P0[3],P0[4],P0[5],     pw0[0]=PKW(P0,0), pw0[1]=PKW(P0,2), pw0); \
    VRD(4); SBAR(); GAPA(C1=__builtin_amdgcn_mfma_f32_32x32x16_bf16(kf[1],qr[0],C1,0,0,0), P0[6],P0[7],P0[8],P0[9],     pw0[2]=PKW(P0,4), pw0[3]=PKW(P0,6), pw0); \
    VRD(1); SBAR(); GAPA(C0=__builtin_amdgcn_mfma_f32_32x32x16_bf16(kf[2],qr[1],C0,0,0,0),   P0[10],P0[11],P0[12],P0[13], pw1[0]=PKW(P0,8), pw1[1]=PKW(P0,10), pw1); \
    VRD(5); SBAR(); GAPA(C1=__builtin_amdgcn_mfma_f32_32x32x16_bf16(kf[3],qr[1],C1,0,0,0),   P0[14],P0[15],P1[0],P1[1],   pw1[2]=PKW(P0,12),pw1[3]=PKW(P0,14), pw1); \
    VRD(2); SBAR(); GAPA(C0=__builtin_amdgcn_mfma_f32_32x32x16_bf16(kf[4],qr[2],C0,0,0,0),   P1[2],P1[3],P1[4],P1[5],     pw2[0]=PKW(P1,0), pw2[1]=PKW(P1,2), pw2); \
    VRD(6); SBAR(); GAPA(C1=__builtin_amdgcn_mfma_f32_32x32x16_bf16(kf[5],qr[2],C1,0,0,0),   P1[6],P1[7],P1[8],P1[9],     pw2[2]=PKW(P1,4), pw2[3]=PKW(P1,6), pw2); \
    VRD(3); SBAR(); GAPA(C0=__builtin_amdgcn_mfma_f32_32x32x16_bf16(kf[6],qr[3],C0,0,0,0),   P1[10],P1[11],P1[12],P1[13], pw3[0]=PKW(P1,8), pw3[1]=PKW(P1,10), pw3); \
    VRD(7); SBAR(); GAPA(C1=__builtin_amdgcn_mfma_f32_32x32x16_bf16(kf[7],qr[3],C1,0,0,0),   P1[14],P1[15],0.f,0.f,       pw3[2]=PKW(P1,12),pw3[3]=PKW(P1,14), pw3); \
    l_reg+=sacc; \
    if(GK){DMA_K((t)+3,sl_cur);} if(GV){DMA_V((t)+1,sl_next);} \
    CMASK(C0,C1,t); SBAR(); \
    GAPB(o[0]=__builtin_amdgcn_mfma_f32_32x32x16_bf16(PAF(0),VFR(0),o[0],0,0,0), C0,0); \
    GAPB(o[1]=__builtin_amdgcn_mfma_f32_32x32x16_bf16(PAF(0),VFR(4),o[1],0,0,0), C0,4); \
    KRD(GL,0); GAPB(o[0]=__builtin_amdgcn_mfma_f32_32x32x16_bf16(PAF(1),VFR(1),o[0],0,0,0), C0,8); \
    KRD(GL,1); GAPB(o[1]=__builtin_amdgcn_mfma_f32_32x32x16_bf16(PAF(1),VFR(5),o[1],0,0,0), C0,12); \
    KRD(GL,2); GAPB(o[0]=__builtin_amdgcn_mfma_f32_32x32x16_bf16(PAF(2),VFR(2),o[0],0,0,0), C1,0); \
    KRD(GL,3); GAPB(o[1]=__builtin_amdgcn_mfma_f32_32x32x16_bf16(PAF(2),VFR(6),o[1],0,0,0), C1,4); \
    GAPB(o[0]=__builtin_amdgcn_mfma_f32_32x32x16_bf16(PAF(3),VFR(3),o[0],0,0,0), C1,8); \
    GAPB(o[1]=__builtin_amdgcn_mfma_f32_32x32x16_bf16(PAF(3),VFR(7),o[1],0,0,0), C1,12); \
    }while(0)
  int t=1;
  #undef CMASK
  #define CMASK(P0,P1,t) do{}while(0)
  for(;t+5<NT;t+=2){
    STEP(pB0,pB1,pA0,pA1,t,true,true,true);     WAIT_BAR(2); RESC(); ROT();
    STEP(pA0,pA1,pB0,pB1,t+1,true,true,true);   WAIT_BAR(2); RESC(); ROT();
  }
  #undef CMASK
  #define CMASK(P0,P1,t) do{int jb_=(t)-(NT-4); if(jb_>=0)cmask(P0,P1,jb_,qrel,hi);}while(0)
  #define ENDW(tt) do{ if((tt)+3<NT){WAIT_BAR(2);} else if((tt)+2<NT){WAIT_BAR(1);} else {WAIT_BAR(0);} }while(0)
  for(;t+1<NT;t+=2){
    STEP(pB0,pB1,pA0,pA1,t,(t+3<NT),(t+1<NT),(t+1<NT));       ENDW(t);   RESC(); ROT();
    STEP(pA0,pA1,pB0,pB1,t+1,(t+4<NT),(t+2<NT),(t+2<NT));     ENDW(t+1); RESC(); ROT();
  }
  STEP(pB0,pB1,pA0,pA1,NT-1,false,false,false); RESC();
  if(hasnext){ const bf16*ksn=Kn+(rowbase+(long)t0n*KVBLK)*DM+(long)lane*DM+wid*8; const bf16*Qwn=Qn+(rowbase+(long)qbn*QB+wid*QBLK)*DM;
    glds16(ksn,(unsigned)__builtin_amdgcn_readfirstlane(kdst)); glds16(ksn+(long)KVBLK*DM,(unsigned)__builtin_amdgcn_readfirstlane(kdst+SLOTB)); glds16(ksn+2L*KVBLK*DM,(unsigned)__builtin_amdgcn_readfirstlane(kdst+2*SLOTB));
    _Pragma("unroll") for(int d0=0;d0<4;++d0)qr[d0]=*reinterpret_cast<const bf16x8*>(&Qwn[(long)r32*DM+d0*16+hi*8]); }
  { float sacc=pB0[0]+pB0[1]; _Pragma("unroll") for(int r=2;r<16;++r)sacc+=pB0[r]; _Pragma("unroll") for(int r=0;r<16;++r)sacc+=pB1[r]; l_reg+=sacc;
    pw0=(u32x4){PKW(pB0,0),PKW(pB0,2),PKW(pB0,4),PKW(pB0,6)};pw1=(u32x4){PKW(pB0,8),PKW(pB0,10),PKW(pB0,12),PKW(pB0,14)};pw2=(u32x4){PKW(pB1,0),PKW(pB1,2),PKW(pB1,4),PKW(pB1,6)};pw3=(u32x4){PKW(pB1,8),PKW(pB1,10),PKW(pB1,12),PKW(pB1,14)};
    SBAR(); pv(o,vb0+sl_cur,PAF(0),PAF(1),PAF(2),PAF(3)); }
  #undef PKW
  #undef PAF
  #undef VFR
  #undef PIN
  #undef MX3
  #undef GAPA
  #undef GAPB
  #undef EX
  #undef VRD
  #undef KRD
  #undef STEP
  #undef ENDW
  {auto rr=__builtin_amdgcn_permlane32_swap(__float_as_uint(l_reg),__float_as_uint(l_reg),false,false);l_reg=__uint_as_float(rr[0])+__uint_as_float(rr[1]);}
  if(hi==0)wsf[32+r32]=l_reg;asm volatile("s_waitcnt lgkmcnt(0)":::"memory");
  float rli[16];
  #pragma unroll
  for(int r=0;r<16;++r)rli[r]=__builtin_amdgcn_rcpf(wsf[32+crow(r,hi)]);
  bf16*Ow=O+(rowbase+q0+wid*QBLK)*DM;
  { bf16*stg=(bf16*)(shm+LDS_OST)+wid*2048;
    #pragma unroll
    for(int r=0;r<16;++r){const int orow=crow(r,hi);
      #pragma unroll
      for(int d0=0;d0<2;++d0)stg[orow*64+d0*32+r32]=__float2bfloat16(o[d0][r]*rli[r]);}
    asm volatile("s_waitcnt lgkmcnt(0)":::"memory");
    #pragma unroll
    for(int i=0;i<4;++i){const int row=i*8+(lane>>3),ch=lane&7; const u32x4 v=*(const u32x4*)(stg+row*64+ch*8); ATTN_STORE16(Ow+(long)row*DM+ch*8,v);} }
  asm volatile("s_waitcnt lgkmcnt(0)\n\ts_barrier":::"memory");
  #undef INITC
  #undef SADD
  #undef ADD32
  #undef DMA_K
  #undef DMA_V
  #undef CMASK
  #undef START
  #undef RESC
  #undef ROT
}

constexpr int ATTN_LDS_BYTES=LDS_BYTES;
#undef SBAR
#undef WAIT_BAR
}
__device__ __forceinline__ float lam_value(const float* q1, const float* k1, const float* q2, const float* k2, int lane) {
    const float a = wave_sum(q1[lane] * k1[lane]), b = wave_sum(q2[lane] * k2[lane]);
    return __expf(a) - __expf(b) + LAM0;
}
template <int NR>
__device__ __forceinline__ void combine_rows(const bf16* O0, const bf16* O1, bf16* MIX, const float* sg, float lam, int row, int stride, int lane) {
    u32x4 a[NR], b[NR];
#pragma unroll
    for (int k = 0; k < NR; ++k) { a[k] = *(const u32x4*)(O0 + (size_t)(row + k * stride) * 512 + 8 * lane); b[k] = *(const u32x4*)(O1 + (size_t)(row + k * stride) * 512 + 8 * lane); }
    const f32x4 g0 = *(const f32x4*)(sg + (8 * lane & 127)), g1 = *(const f32x4*)(sg + (8 * lane & 127) + 4);
#pragma unroll
    for (int k = 0; k < NR; ++k) { float v[8]; float s = 0.f;
#pragma unroll
        for (int i = 0; i < 4; ++i) { v[2 * i] = bflo(a[k][i]) - lam * bflo(b[k][i]); v[2 * i + 1] = bfhi(a[k][i]) - lam * bfhi(b[k][i]); s += v[2 * i] * v[2 * i] + v[2 * i + 1] * v[2 * i + 1]; }
        s = row_allsum(s);
        const float rinv = (1.f - LAM0) / sqrtf(s * (1.f / VD) + EPS);
        u32x4 o; o.x = pk2(v[0] * rinv * g0[0], v[1] * rinv * g0[1]); o.y = pk2(v[2] * rinv * g0[2], v[3] * rinv * g0[3]);
        o.z = pk2(v[4] * rinv * g1[0], v[5] * rinv * g1[1]); o.w = pk2(v[6] * rinv * g1[2], v[7] * rinv * g1[3]);
        *(u32x4*)(MIX + (size_t)(row + k * stride) * 1024 + 512 + 8 * lane) = o; }
}
constexpr int SA_SC = 0, SA_PL = 16384, SA_ACC = 32768, SA_ML = 98304, SA_FIN = 99328;
__device__ __forceinline__ void sattn_unit(const bf16* Qb, const bf16* Kb, const bf16* Vb, const float* ck, const float* cv, const int* pt, bf16* MIX, const float* sg, float lam,
                                           int s, int h, int c0, LAS unsigned char* lds, int tid_in) {
    int tid = tid_in; asm volatile("" : "+v"(tid));
    const int lane = tid & 63, w = __builtin_amdgcn_readfirstlane(tid >> 6);
    const float slope2 = exp2f(-2.f * (float)(h + 1)) * LOG2E;
    LAS float* sc = (LAS float*)(lds + SA_SC) + w * 512;
    LAS float* pl = (LAS float*)(lds + SA_PL) + w * 512;
    LAS float* accm = (LAS float*)(lds + SA_ACC);
    LAS float* ml = (LAS float*)(lds + SA_ML);
    LAS float* fin = (LAS float*)(lds + SA_FIN);
    const int r32 = lane & 31, hi = lane >> 5;
    bf16x8 qf[2][4];
#pragma unroll
    for (int mp = 0; mp < 2; ++mp)
#pragma unroll
        for (int ks = 0; ks < 4; ++ks) qf[mp][ks] = *(const bf16x8*)(Qb + (size_t)(MP + 4 * s + (r32 & 3)) * 512 + h * 128 + mp * 64 + 16 * ks + 8 * hi);
    float mrun[8], lrun[8], acc[8][4];
#pragma unroll
    for (int c = 0; c < 8; ++c) { mrun[c] = -INFINITY; lrun[c] = 0.f; acc[c][0] = 0.f; acc[c][1] = 0.f; acc[c][2] = 0.f; acc[c][3] = 0.f; }
    for (int chunk = c0 + w; chunk < 32; chunk += 8) {
        const int page = pt[s * NPAGES + (chunk >> 1)];
        const size_t tok0 = (size_t)page * PAGE + (chunk & 1) * 64;
        const int kp0 = 64 * chunk;
#pragma unroll
        for (int mp = 0; mp < 2; ++mp) {
            f32x4 kk[2][4][2];
#pragma unroll
            for (int kb = 0; kb < 2; ++kb)
#pragma unroll
                for (int ks = 0; ks < 4; ++ks) { const float* kp = ck + ((tok0 + kb * 32 + r32) * NH + h) * 128 + mp * 64 + 16 * ks + 8 * hi;
                    kk[kb][ks][0] = *(const f32x4*)kp; kk[kb][ks][1] = *(const f32x4*)(kp + 4); }
            asm volatile("s_waitcnt vmcnt(0)" ::: "memory");
#pragma unroll
            for (int kb = 0; kb < 2; ++kb) { f32x16 sa = {};
#pragma unroll
                for (int ks = 0; ks < 4; ++ks) { const u32x4 kw = ep::pack8(kk[kb][ks][0], kk[kb][ks][1]);
                    sa = __builtin_amdgcn_mfma_f32_32x32x16_bf16(__builtin_bit_cast(bf16x8, kw), qf[mp][ks], sa, 0, 0, 0); }
                if (r32 < 4) {
#pragma unroll
                    for (int r = 0; r < 16; ++r) sc[(mp * 4 + r32) * 64 + kb * 32 + (r & 3) + 8 * (r >> 2) + 4 * hi] = sa[r]; } }
        }
        LDS_WAIT(); asm volatile("" ::: "memory");
#pragma unroll
        for (int c = 0; c < 8; ++c) { const int t = c & 3;
            const float sv = sc[c * 64 + lane] - slope2 * (float)(PAST + t - (kp0 + lane));
            const float mn = __builtin_bit_cast(float, __builtin_amdgcn_readfirstlane(__builtin_bit_cast(int, fmaxf(mrun[c], wave_max(sv))))); const float p = __builtin_amdgcn_exp2f(sv - mn);
            const float fsc_ = __builtin_amdgcn_exp2f(mrun[c] - mn); lrun[c] = __builtin_bit_cast(float, __builtin_amdgcn_readfirstlane(__builtin_bit_cast(int, lrun[c] * fsc_ + wave_sum(p)))); mrun[c] = mn; pl[lane * 8 + c] = p; acc[c][0] *= fsc_; acc[c][1] *= fsc_; acc[c][2] *= fsc_; acc[c][3] *= fsc_; }
        LDS_WAIT(); asm volatile("" ::: "memory");
        const float* vp = cv + ((tok0 + hi) * NH + h) * 128 + 4 * r32;
#pragma unroll 1
        for (int k0 = 0; k0 < 64; k0 += 16) { f32x4 vv[8];
#pragma unroll
            for (int k = 0; k < 8; ++k) vv[k] = *(const f32x4*)(vp + (size_t)(k0 + 2 * k) * NH * 128);
            asm volatile("s_waitcnt vmcnt(0)" ::: "memory");
#pragma unroll
            for (int k = 0; k < 8; ++k) { const f32x4 v4 = vv[k]; const LAS float* pp = pl + (k0 + 2 * k + hi) * 8; const f32x4 p0 = *(const LAS f32x4*)pp, p1 = *(const LAS f32x4*)(pp + 4);
#pragma unroll
                for (int c = 0; c < 4; ++c)
#pragma unroll
                    for (int i = 0; i < 4; ++i) { acc[c][i] += p0[c] * v4[i]; acc[4 + c][i] += p1[c] * v4[i]; } } }
        LDS_WAIT(); asm volatile("" ::: "memory");
    }
#pragma unroll
    for (int c = 0; c < 8; ++c) { *(LAS f32x4*)(accm + ((2 * w + hi) * 8 + c) * 128 + 4 * r32) = (f32x4){acc[c][0], acc[c][1], acc[c][2], acc[c][3]}; }
    if (lane == 0) {
#pragma unroll
        for (int c = 0; c < 8; ++c) { ml[w * 8 + c] = mrun[c]; ml[64 + w * 8 + c] = lrun[c]; } }
    __syncthreads();
    { const int map = w >> 2, t = w & 3;
      const float q = bf2f(Qb[(size_t)(MP + 4 * s + t) * 512 + h * 128 + map * 64 + lane]);
      float sn[4];
#pragma unroll
      for (int t2 = 0; t2 < 4; ++t2) { const float kk = bf2f(Kb[(size_t)(MP + 4 * s + t2) * 512 + h * 128 + map * 64 + lane]); sn[t2] = wave_sum(q * kk) - slope2 * (float)(t - t2); if (t2 > t) sn[t2] = -INFINITY; }
      float M = fmaxf(fmaxf(sn[0], sn[1]), fmaxf(sn[2], sn[3]));
#pragma unroll
      for (int w2 = 0; w2 < 8; ++w2) M = fmaxf(M, ml[w2 * 8 + w]);
      float L = 0.f, o0 = 0.f, o1 = 0.f;
#pragma unroll
      for (int w2 = 0; w2 < 8; ++w2) { const float f = __builtin_amdgcn_exp2f(ml[w2 * 8 + w] - M); L += ml[64 + w2 * 8 + w] * f;
          const f32x2 a = *(const LAS f32x2*)(accm + ((2 * w2) * 8 + w) * 128 + 2 * lane), b2 = *(const LAS f32x2*)(accm + ((2 * w2 + 1) * 8 + w) * 128 + 2 * lane); o0 += (a[0] + b2[0]) * f; o1 += (a[1] + b2[1]) * f; }
#pragma unroll
      for (int t2 = 0; t2 < 4; ++t2) { const float p = __builtin_amdgcn_exp2f(sn[t2] - M); L += p; const unsigned vv = *(const unsigned*)(Vb + (size_t)(MP + 4 * s + t2) * 512 + h * 128 + 2 * lane); o0 += p * bflo(vv); o1 += p * bfhi(vv); }
      const float rl = 1.f / L;
      *(LAS f32x2*)(fin + w * 128 + 2 * lane) = (f32x2){o0 * rl, o1 * rl}; }
    __syncthreads();
    if (w < 4) { const f32x2 a = *(const LAS f32x2*)(fin + w * 128 + 2 * lane), b = *(const LAS f32x2*)(fin + (4 + w) * 128 + 2 * lane);
        const float v0 = a[0] - lam * b[0], v1 = a[1] - lam * b[1]; const float ss = wave_sum(v0 * v0 + v1 * v1);
        const float rinv = (1.f - LAM0) / sqrtf(ss * (1.f / VD) + EPS);
        *(unsigned*)(MIX + (size_t)(MP + 4 * s + w) * 1024 + 512 + h * 128 + 2 * lane) = pk2(v0 * rinv * sg[2 * lane], v1 * rinv * sg[2 * lane + 1]); }
    __syncthreads();
}
constexpr int XS_SC = 0, XS_P = 4096, XS_ACC = 8192;
__device__ __forceinline__ void xattn_sample_unit(const bf16* CQ, const float* SSQ, const float* cmk, const float* cmv, bf16* CO, int s, int h, LAS unsigned char* lds, int tid) {
    const int lane = tid & 63, w = __builtin_amdgcn_readfirstlane(tid >> 6);
    LAS float* scx = (LAS float*)(lds + XS_SC); LAS float* px = (LAS float*)(lds + XS_P); LAS float* accx = (LAS float*)(lds + XS_ACC);
    { const int r32 = lane & 31, hi = lane >> 5, t = r32 & 3;
      const f32x4 pq = *(const f32x4*)(SSQ + (size_t)(4 * s + t) * 16 + 4 * h); const float qs = 1.f / sqrtf(((pq[0] + pq[1]) + (pq[2] + pq[3])) * (1.f / 256.f) + EPS);
      const float* kp = cmk + (((size_t)s * NMEM + 32 * w + r32) * CAH + h) * CAD + 8 * hi; const bf16* qp = CQ + (size_t)(MP + 4 * s + t) * 1024 + h * 256 + 8 * hi;
      f32x16 sa = {};
      { f32x4 kk[16][2]; bf16x8 qf[16];
#pragma unroll
        for (int ks = 0; ks < 16; ++ks) { kk[ks][0] = *(const f32x4*)(kp + 16 * ks); kk[ks][1] = *(const f32x4*)(kp + 16 * ks + 4); qf[ks] = *(const bf16x8*)(qp + 16 * ks); }
        asm volatile("" ::: "memory");
#pragma unroll
        for (int ks = 0; ks < 16; ++ks) { const u32x4 kw = ep::pack8(kk[ks][0], kk[ks][1]); sa = __builtin_amdgcn_mfma_f32_32x32x16_bf16(__builtin_bit_cast(bf16x8, kw), qf[ks], sa, 0, 0, 0); } }
      if (r32 < 4) {
#pragma unroll
          for (int r = 0; r < 16; ++r) scx[r32 * 256 + 32 * w + (r & 3) + 8 * (r >> 2) + 4 * hi] = sa[r] * qs; } }
    f32x4 vv[32];
    { const float* vb = cmv + (((size_t)s * NMEM + 32 * w) * CAH + h) * CAD + 4 * lane;
#pragma unroll
      for (int j = 0; j < 32; ++j) vv[j] = *(const f32x4*)(vb + (size_t)j * CAH * CAD);
      asm volatile("" ::: "memory"); }
    asm volatile("s_waitcnt lgkmcnt(0)\n\ts_barrier" ::: "memory");
    if (w < 4) { float sv[4]; float mx = -INFINITY;
#pragma unroll
        for (int j = 0; j < 4; ++j) { sv[j] = scx[w * 256 + lane + 64 * j]; mx = fmaxf(mx, sv[j]); }
        mx = wave_max(mx); float sum = 0.f;
#pragma unroll
        for (int j = 0; j < 4; ++j) { sv[j] = __builtin_amdgcn_exp2f(sv[j] - mx); sum += sv[j]; }
        const float rl = 1.f / wave_sum(sum);
#pragma unroll
        for (int j = 0; j < 4; ++j) px[w * 256 + lane + 64 * j] = sv[j] * rl; }
    asm volatile("s_waitcnt lgkmcnt(0)\n\ts_barrier" ::: "memory");
    { float acc[4][4];
#pragma unroll
      for (int t = 0; t < 4; ++t)
#pragma unroll
          for (int i = 0; i < 4; ++i) acc[t][i] = 0.f;
#pragma unroll
      for (int j = 0; j < 32; ++j) { const f32x4 v = vv[j];
#pragma unroll
          for (int t = 0; t < 4; ++t) { const float p = px[t * 256 + 32 * w + j];
#pragma unroll
              for (int i = 0; i < 4; ++i) acc[t][i] += p * v[i]; } }
#pragma unroll
      for (int t = 0; t < 4; ++t) *(LAS f32x4*)(accx + (w * 4 + t) * 256 + 4 * lane) = (f32x4){acc[t][0], acc[t][1], acc[t][2], acc[t][3]}; }
    __syncthreads();
    { const int t = tid >> 7, dv = (tid & 127) * 2; float o0 = 0.f, o1 = 0.f;
#pragma unroll
      for (int w2 = 0; w2 < 8; ++w2) { const f32x2 a = *(const LAS f32x2*)(accx + (w2 * 4 + t) * 256 + dv); o0 += a[0]; o1 += a[1]; }
      *(unsigned*)(CO + (size_t)(MP + 4 * s + t) * 1024 + h * 256 + dv) = pk2(o0, o1); }
    __syncthreads();
}
constexpr int XP_KP = 528, XP_VP = 320, XP_K = 0, XP_V = 64 * XP_KP, XP_F = XP_V + 64 * XP_VP;
typedef short v4i16_t __attribute__((ext_vector_type(4)));
__device__ __forceinline__ void xattn_prompt_unit(const bf16* CQ, const bf16* MKb, const bf16* MVb, bf16* CO, int rt, int h, int dvh, LAS unsigned char* lds, int tid) {
    const int lane = tid & 63, w = __builtin_amdgcn_readfirstlane(tid >> 6), r32 = lane & 31, hi = lane >> 5, b = rt >> 4;
    LAS unsigned char* Kt = lds + XP_K; LAS unsigned char* Vt = lds + XP_V; LAS float* fsc = (LAS float*)(lds + XP_F) + w * 32;
    bf16x8 qf[16];
    { const bf16* qp = CQ + (size_t)(256 * rt + 32 * w + r32) * 1024 + h * 256 + 8 * hi;
#pragma unroll
      for (int ds = 0; ds < 16; ++ds) qf[ds] = *(const bf16x8*)(qp + 16 * ds); }
    f32x16 o[4]; o[0] = f32x16{}; o[1] = f32x16{}; o[2] = f32x16{}; o[3] = f32x16{};
    float mrow = -INFINITY, lrow = 0.f;
    for (int kt = 0; kt < 4; ++kt) {
        const size_t krow0 = (size_t)b * NMEM + 64 * kt;
#pragma unroll
        for (int it = 0; it < 4; ++it) { const int idx = tid + 512 * it, key = idx >> 5, c = idx & 31;
            *(LAS u32x4*)(Kt + key * XP_KP + c * 16) = *(const u32x4*)(MKb + (krow0 + key) * 1024 + h * 256 + c * 8); }
#pragma unroll
        for (int it = 0; it < 2; ++it) { const int idx = tid + 512 * it, key = idx >> 4, c = idx & 15;
            *(LAS u32x4*)(Vt + key * XP_VP + c * 16) = *(const u32x4*)(MVb + (krow0 + key) * 1024 + h * 256 + dvh * 128 + c * 8); }
        __syncthreads();
        f32x16 p0 = f32x16{}, p1 = f32x16{};
#pragma unroll
        for (int ds = 0; ds < 16; ++ds) { const bf16x8 k0 = *(const LAS bf16x8*)(Kt + r32 * XP_KP + (16 * ds + 8 * hi) * 2), k1 = *(const LAS bf16x8*)(Kt + (32 + r32) * XP_KP + (16 * ds + 8 * hi) * 2);
            p0 = __builtin_amdgcn_mfma_f32_32x32x16_bf16(k0, qf[ds], p0, 0, 0, 0); p1 = __builtin_amdgcn_mfma_f32_32x32x16_bf16(k1, qf[ds], p1, 0, 0, 0); }
        float mx = fmaxf(p0[0], p1[0]);
#pragma unroll
        for (int r = 1; r < 16; ++r) mx = fmaxf(mx, fmaxf(p0[r], p1[r]));
        mx = fmaxf(mx, __shfl_xor(mx, 32));
        const float mn = fmaxf(mrow, mx), f = __builtin_amdgcn_exp2f(mrow - mn); mrow = mn;
        float ls = 0.f;
#pragma unroll
        for (int r = 0; r < 16; ++r) { p0[r] = __builtin_amdgcn_exp2f(p0[r] - mn); p1[r] = __builtin_amdgcn_exp2f(p1[r] - mn); ls += p0[r] + p1[r]; }
        lrow = lrow * f + ls;
        if (hi == 0) fsc[r32] = f;
        LDS_WAIT(); asm volatile("" ::: "memory");
#pragma unroll
        for (int r = 0; r < 16; ++r) { const float fr_ = fsc[(r & 3) + 8 * (r >> 2) + 4 * hi];
#pragma unroll
            for (int d = 0; d < 4; ++d) o[d][r] *= fr_; }
        u32x4 pa[2][2];
#pragma unroll
        for (int s2 = 0; s2 < 2; ++s2) { pa[0][s2] = (u32x4){pg8::cvt_pk_bf16(p0[8 * s2], p0[8 * s2 + 1]), pg8::cvt_pk_bf16(p0[8 * s2 + 2], p0[8 * s2 + 3]), pg8::cvt_pk_bf16(p0[8 * s2 + 4], p0[8 * s2 + 5]), pg8::cvt_pk_bf16(p0[8 * s2 + 6], p0[8 * s2 + 7])};
            pa[1][s2] = (u32x4){pg8::cvt_pk_bf16(p1[8 * s2], p1[8 * s2 + 1]), pg8::cvt_pk_bf16(p1[8 * s2 + 2], p1[8 * s2 + 3]), pg8::cvt_pk_bf16(p1[8 * s2 + 4], p1[8 * s2 + 5]), pg8::cvt_pk_bf16(p1[8 * s2 + 6], p1[8 * s2 + 7])}; }
        const LAS unsigned char* vb = Vt + (4 * hi + ((lane & 15) >> 2)) * XP_VP + (16 * ((lane >> 4) & 1) + 4 * (lane & 3)) * 2;
#pragma unroll
        for (int d = 0; d < 4; ++d)
#pragma unroll
            for (int kb = 0; kb < 2; ++kb)
#pragma unroll
                for (int s2 = 0; s2 < 2; ++s2) { const LAS unsigned char* p = vb + (32 * kb + 16 * s2) * XP_VP + d * 64;
                    const v4i16_t lo = __builtin_amdgcn_ds_read_tr16_b64_v4i16((LAS v4i16_t*)p), hh = __builtin_amdgcn_ds_read_tr16_b64_v4i16((LAS v4i16_t*)(p + 8 * XP_VP));
                    const bf16x8 vf = (bf16x8){lo[0], lo[1], lo[2], lo[3], hh[0], hh[1], hh[2], hh[3]};
                    o[d] = __builtin_amdgcn_mfma_f32_32x32x16_bf16(__builtin_bit_cast(bf16x8, pa[kb][s2]), vf, o[d], 0, 0, 0); }
        __syncthreads();
    }
    lrow += __shfl_xor(lrow, 32);
    if (hi == 0) fsc[r32] = 1.f / lrow;
    LDS_WAIT(); asm volatile("" ::: "memory");
#pragma unroll
    for (int r = 0; r < 16; ++r) { const int qr = (r & 3) + 8 * (r >> 2) + 4 * hi; const float rl = fsc[qr];
        bf16* op = CO + (size_t)(256 * rt + 32 * w + qr) * 1024 + h * 256 + dvh * 128 + r32;
#pragma unroll
        for (int d = 0; d < 4; ++d) op[32 * d] = (bf16)f2bf(o[d][r] * rl); }
    __syncthreads();
}
constexpr int X2_KP = 528, X2_VP = 576, X2_K = 0, X2_V = 64 * X2_KP, X2_MX = X2_V + 64 * X2_VP, X2_PEX = X2_MX + 1024, X2_F = X2_PEX + 16384;
__device__ __forceinline__ void xattn_prompt_unit2(const bf16* CQ, const bf16* MKb, const bf16* MVb, bf16* CO, int rt, int h, float mref, LAS unsigned char* lds, int tid_in) {
    int tid = tid_in; asm volatile("" : "+v"(tid));
    const int lane = tid & 63, w = __builtin_amdgcn_readfirstlane(tid >> 6), r32 = lane & 31, hi = lane >> 5, b = rt >> 5, pr = w >> 1, which = w & 1;
    LAS unsigned char* Kt = lds + X2_K; LAS unsigned char* Vt = lds + X2_V; LAS float* fsc = (LAS float*)(lds + X2_F) + w * 32;
    LAS float* mxo = (LAS float*)(lds + X2_MX) + (pr * 2 + which) * 32; LAS float* mxp = (LAS float*)(lds + X2_MX) + (pr * 2 + (which ^ 1)) * 32;
    LAS u32x4* peo = (LAS u32x4*)(lds + X2_PEX) + (pr * 2 + which) * 128; const LAS u32x4* pex0 = (const LAS u32x4*)(lds + X2_PEX) + (pr * 2) * 128;
    bf16x8 qf[16];
    { const bf16* qp = CQ + (size_t)(128 * rt + 32 * pr + r32) * 1024 + h * 256 + 8 * hi;
#pragma unroll
      for (int ds = 0; ds < 16; ++ds) qf[ds] = *(const bf16x8*)(qp + 16 * ds); }
    f32x16 o[4]; o[0] = f32x16{}; o[1] = f32x16{}; o[2] = f32x16{}; o[3] = f32x16{};
    float lrow = 0.f;
#define X2_LBAR() asm volatile("s_waitcnt lgkmcnt(0)\n\ts_barrier" ::: "memory")
    u32x4 kpre[4], vpre[4];
    { const size_t krow0 = (size_t)b * NMEM;
#pragma unroll
      for (int it = 0; it < 4; ++it) { const int idx = tid + 512 * it, key = idx >> 5, c = idx & 31;
          kpre[it] = *(const u32x4*)(MKb + (krow0 + key) * 1024 + h * 256 + c * 8); vpre[it] = *(const u32x4*)(MVb + (krow0 + key) * 1024 + h * 256 + c * 8); } }
#pragma unroll
    for (int kt = 0; kt < 4; ++kt) {
#pragma unroll
        for (int it = 0; it < 4; ++it) { const int idx = tid + 512 * it, key = idx >> 5, c = idx & 31;
            *(LAS u32x4*)(Kt + key * X2_KP + c * 16) = kpre[it]; *(LAS u32x4*)(Vt + key * X2_VP + c * 16) = vpre[it]; }
        if (kt < 3) { const size_t krow0 = (size_t)b * NMEM + 64 * (kt + 1);
#pragma unroll
            for (int it = 0; it < 4; ++it) { const int idx = tid + 512 * it, key = idx >> 5, c = idx & 31;
                kpre[it] = *(const u32x4*)(MKb + (krow0 + key) * 1024 + h * 256 + c * 8); vpre[it] = *(const u32x4*)(MVb + (krow0 + key) * 1024 + h * 256 + c * 8); }
            asm volatile("" ::: "memory"); }
        X2_LBAR();
        f32x16 p = f32x16{};
#pragma unroll
        for (int ds = 0; ds < 16; ++ds) { const bf16x8 k0 = *(const LAS bf16x8*)(Kt + (32 * which + r32) * X2_KP + (16 * ds + 8 * hi) * 2);
            p = __builtin_amdgcn_mfma_f32_32x32x16_bf16(k0, qf[ds], p, 0, 0, 0); }
        float ls = 0.f;
#pragma unroll
        for (int r = 0; r < 16; ++r) { p[r] = __builtin_amdgcn_exp2f(p[r] - mref); ls += p[r]; }
        lrow += ls;
#pragma unroll
        for (int s2 = 0; s2 < 2; ++s2) peo[s2 * 64 + lane] = (u32x4){pg8::cvt_pk_bf16(p[8 * s2], p[8 * s2 + 1]), pg8::cvt_pk_bf16(p[8 * s2 + 2], p[8 * s2 + 3]), pg8::cvt_pk_bf16(p[8 * s2 + 4], p[8 * s2 + 5]), pg8::cvt_pk_bf16(p[8 * s2 + 6], p[8 * s2 + 7])};
        X2_LBAR();
        u32x4 pa[2][2];
#pragma unroll
        for (int s2 = 0; s2 < 2; ++s2) { pa[0][s2] = pex0[s2 * 64 + lane]; pa[1][s2] = pex0[128 + s2 * 64 + lane]; }
        const LAS unsigned char* vb = Vt + (4 * hi + ((lane & 15) >> 2)) * X2_VP + (128 * which + 16 * ((lane >> 4) & 1) + 4 * (lane & 3)) * 2;
#pragma unroll
        for (int d = 0; d < 4; ++d)
#pragma unroll
            for (int kb = 0; kb < 2; ++kb)
#pragma unroll
                for (int s2 = 0; s2 < 2; ++s2) { const LAS unsigned char* pp = vb + (32 * kb + 16 * s2) * X2_VP + d * 64;
                    const v4i16_t lo = __builtin_amdgcn_ds_read_tr16_b64_v4i16((LAS v4i16_t*)pp), hh = __builtin_amdgcn_ds_read_tr16_b64_v4i16((LAS v4i16_t*)(pp + 8 * X2_VP));
                    const bf16x8 vf = (bf16x8){lo[0], lo[1], lo[2], lo[3], hh[0], hh[1], hh[2], hh[3]};
                    o[d] = __builtin_amdgcn_mfma_f32_32x32x16_bf16(__builtin_bit_cast(bf16x8, pa[kb][s2]), vf, o[d], 0, 0, 0);
                    if (kb == 1 && s2 == 1) __builtin_amdgcn_sched_barrier(0); }
        X2_LBAR();
    }
    lrow += __shfl_xor(lrow, 32);
    if (hi == 0) mxo[r32] = lrow;
    __syncthreads();
    if (hi == 0) fsc[r32] = 1.f / (lrow + mxp[r32]);
    LDS_WAIT(); asm volatile("" ::: "memory");
#pragma unroll
    for (int r = 0; r < 16; ++r) { const int qr = (r & 3) + 8 * (r >> 2) + 4 * hi; const float rl = fsc[qr];
        bf16* op = CO + (size_t)(128 * rt + 32 * pr + qr) * 1024 + h * 256 + 128 * which + r32;
#pragma unroll
        for (int d = 0; d < 4; ++d) op[32 * d] = (bf16)f2bf(o[d][r] * rl); }
    __syncthreads();
}
#undef X2_LBAR
template <int NKS, bool ATILED = false, bool FFN = false, bool HALF = false, class EF>
__device__ __forceinline__ void mini_gemm(const bf16* A, const bf16* Wt, int N, int first, int ncu, int bid, LAS unsigned char* lds, int tid, const EF& ef, unsigned* qctr = nullptr, volatile LAS int* qslot = nullptr) {
    const int lane = tid & 63, w = __builtin_amdgcn_readfirstlane(tid >> 6), c16 = lane & 15, kq = lane >> 4;
    static_assert(NKS % 2 == 0, "the waves' K slices are whole 32-wide k-steps");
    constexpr int kw = NKS * 16, K = kw * 8, NS = NKS / 2;
    constexpr int RB = HALF ? 32 : 64, MI = RB / 16; const int ncb = N >> 6, npieces = (512 / RB) * ncb;
    if (bid < first || bid >= first + ncu) return;
    LAS float* lf = (LAS float*)lds;
#pragma unroll 1
    for (int pc = bid - first;; pc += ncu) {
        if (qctr) { __syncthreads(); if (tid == 0) qslot[0] = (int)atomicAdd(qctr, 1u); __syncthreads(); pc = __builtin_amdgcn_readfirstlane(qslot[0]); }
        if (pc >= npieces) break;
        const int rb = pc / ncb, cb = pc - rb * ncb;
        const bf16* a0 = ATILED ? A + (size_t)(MP + RB * rb + c16) * 64 : A + (size_t)(RB * rb + c16) * K + w * kw + 8 * kq;
        const bf16* b0 = Wt + (size_t)((cb >> 2) * 256 + 32 * (cb & 3) + c16) * K + w * kw + 8 * kq;
        f32x4 acc[MI][4];
#pragma unroll
        for (int mi = 0; mi < MI; ++mi)
#pragma unroll
            for (int ni = 0; ni < 4; ++ni) acc[mi][ni] = (f32x4){0.f, 0.f, 0.f, 0.f};
        constexpr int SB = NS < 4 ? NS : 4;
#pragma unroll 1
        for (int s0 = 0; s0 < NS; s0 += SB) {
            bf16x8 Af[SB][MI], Bf[SB][4];
#pragma unroll
            for (int j = 0; j < SB; ++j) if (s0 + j < NS) { const int s = s0 + j;
                if (ATILED) { const int kk = w * kw + 32 * s + 8 * kq; const bf16* at = a0 + (size_t)(kk >> 6) * MTOT * 64 + (kk & 63);
#pragma unroll
                    for (int mi = 0; mi < MI; ++mi) Af[j][mi] = *(const bf16x8*)(at + 16 * mi * 64); }
                else {
#pragma unroll
                    for (int mi = 0; mi < MI; ++mi) Af[j][mi] = *(const bf16x8*)(a0 + (size_t)(16 * mi) * K + 32 * s); }
#pragma unroll
                for (int ni = 0; ni < 4; ++ni) Bf[j][ni] = *(const bf16x8*)(b0 + (size_t)(16 * (ni & 1) + 128 * (ni >> 1)) * K + 32 * s); }
            asm volatile("s_waitcnt vmcnt(0)" ::: "memory");
#pragma unroll
            for (int j = 0; j < SB; ++j) if (s0 + j < NS) {
#pragma unroll
                for (int mi = 0; mi < MI; ++mi)
#pragma unroll
                    for (int ni = 0; ni < 4; ++ni) acc[mi][ni] = __builtin_amdgcn_mfma_f32_16x16x32_bf16(Af[j][mi], Bf[j][ni], acc[mi][ni], 0, 0, 0); }
        }
        LAS float* part = lf + w * 4096;
#pragma unroll
        for (int mi = 0; mi < MI; ++mi)
#pragma unroll
            for (int ni = 0; ni < 4; ++ni)
#pragma unroll
                for (int i = 0; i < 4; ++i) part[(16 * mi + 4 * kq + i) * 64 + 16 * ni + c16] = acc[mi][ni][i];
        __syncthreads();
        const int row = tid >> 3, c8 = (tid & 7) * 8; float v[8];
        if (!HALF || tid < 256) {
#pragma unroll
        for (int i = 0; i < 8; ++i) v[i] = 0.f;
#pragma unroll
        for (int w2 = 0; w2 < 8; ++w2) { const f32x4 x = *(const LAS f32x4*)(lf + w2 * 4096 + row * 64 + c8), y = *(const LAS f32x4*)(lf + w2 * 4096 + row * 64 + c8 + 4);
            v[0] += x[0]; v[1] += x[1]; v[2] += x[2]; v[3] += x[3]; v[4] += y[0]; v[5] += y[1]; v[6] += y[2]; v[7] += y[3]; }
        }
        if constexpr (FFN) ef.ffn(lf, 64 * rb + row, row, cb, c8, v);
        else if (!HALF || tid < 256) ef(RB * rb + row, 64 * cb + c8, v, lane);
        __syncthreads();
    }
}
namespace mef {
__device__ __forceinline__ float ss64(const float (&v)[8]) { float s = 0.f;
#pragma unroll
    for (int i = 0; i < 8; ++i) s += v[i] * v[i];
    return oct_allsum(s); }
__device__ __forceinline__ u32x4 pk8(const float (&v)[8]) { u32x4 o; o.x = pk2(v[0], v[1]); o.y = pk2(v[2], v[3]); o.z = pk2(v[4], v[5]); o.w = pk2(v[6], v[7]); return o; }
__device__ __forceinline__ void st8(float* p, const float (&v)[8]) { *(f32x4*)p = (f32x4){v[0], v[1], v[2], v[3]}; *(f32x4*)(p + 4) = (f32x4){v[4], v[5], v[6], v[7]}; }
__device__ __forceinline__ void ld8(const float* p, float (&g)[8]) { const f32x4 a = *(const f32x4*)p, b = *(const f32x4*)(p + 4); g[0] = a[0]; g[1] = a[1]; g[2] = a[2]; g[3] = a[3]; g[4] = b[0]; g[5] = b[1]; g[6] = b[2]; g[7] = b[3]; }
__device__ __forceinline__ void ld8bf(const bf16* p, float (&g)[8]) { const u32x4 w = *(const u32x4*)p; g[0] = bflo(w.x); g[1] = bfhi(w.x); g[2] = bflo(w.y); g[3] = bfhi(w.y); g[4] = bflo(w.z); g[5] = bfhi(w.z); g[6] = bflo(w.w); g[7] = bfhi(w.w); }
struct In { bf16 *UG, *Qb, *Kb, *Vb; float* out; const float *qg, *kg;
    __device__ __forceinline__ void operator()(int r, int c, float (&v)[8], int) const { const size_t gr = (size_t)MP + r;
        if (c < 512) { *(u32x4*)(UG + ((size_t)(c >> 4) * MTOT + gr) * 16 + (c & 15)) = pk8(v); }
        else if (c < 1536) { const bool isq = c < 1024; const float rinv = 1.f / sqrtf(ss64(v) * (1.f / 64.f) + EPS) * (isq ? C2 : 1.f); float g[8]; ld8((isq ? qg : kg) + (c & 63), g);
#pragma unroll
            for (int i = 0; i < 8; ++i) v[i] *= rinv * g[i];
            if (isq) *(u32x4*)(Qb + gr * 512 + (c - 512)) = pk8(v);
            else { *(u32x4*)(Kb + gr * 512 + (c - 1024)) = pk8(v); st8(out + O_KS + (size_t)r * 512 + (c - 1024), v); } }
        else { *(u32x4*)(Vb + gr * 512 + (c - 1536)) = pk8(v); st8(out + O_VS + (size_t)r * 512 + (c - 1536), v); } } };
struct Glu { const bf16* Gb; bf16* MIX;
    __device__ __forceinline__ void operator()(int r, int c, float (&v)[8], int) const { const size_t gr = (size_t)MP + r; float g[8]; ld8bf(Gb + gr * 512 + c, g);
#pragma unroll
        for (int i = 0; i < 8; ++i) v[i] = g[i] * ep::sigm(v[i]);
        *(u32x4*)(MIX + gr * 1024 + c) = pk8(v); } };
template <bool RES_BF16> struct Res { const void* res; bf16* XB; float* SS;
    __device__ __forceinline__ void operator()(int r, int c, float (&v)[8], int lane) const { const size_t gr = (size_t)MP + r; float x[8];
        if (RES_BF16) ld8bf((const bf16*)res + (size_t)r * DMODEL + c, x); else ld8((const float*)res + (size_t)r * DMODEL + c, x);
#pragma unroll
        for (int i = 0; i < 8; ++i) v[i] += x[i];
        const float s = ss64(v); if ((lane & 7) == 0) SS[gr * 16 + (c >> 6)] = s;
        *(u32x4*)(XB + gr * DMODEL + c) = pk8(v); } };
struct Cq { const float* SS; bf16* CQ; float* SSQ; const float* gq;
    __device__ __forceinline__ void operator()(int r, int c, float (&v)[8], int lane) const { const size_t gr = (size_t)MP + r; const float rs = ep::row_rs(SS, (int)gr); float g[8]; ld8(gq + (c & 255), g);
#pragma unroll
        for (int i = 0; i < 8; ++i) v[i] *= rs;
        const float s = ss64(v); if ((lane & 7) == 0) SSQ[(size_t)r * 16 + (c >> 6)] = s;
#pragma unroll
        for (int i = 0; i < 8; ++i) v[i] *= g[i] * CA2;
        *(u32x4*)(CQ + gr * DMODEL + c) = pk8(v); } };
struct Ffn { const float* SS; bf16* H; float* out; const float* cw_; const float* cb_; const float* sconv;
    __device__ __forceinline__ void ffn(LAS float* T, int r, int row, int cb, int c8, float (&v)[8]) const {
        const size_t gr = (size_t)MP + r; const float rs = ep::row_rs(SS, (int)gr);
        __syncthreads();
        *(LAS f32x4*)(T + row * 64 + c8) = (f32x4){v[0] * rs, v[1] * rs, v[2] * rs, v[3] * rs}; *(LAS f32x4*)(T + row * 64 + c8 + 4) = (f32x4){v[4] * rs, v[5] * rs, v[6] * rs, v[7] * rs};
        __syncthreads();
        if (c8 < 32) { const int ch = 128 * (cb >> 2) + 32 * (cb & 3) + c8, t = r & 3; const float* prev = sconv + (size_t)(r >> 2) * 2 * FF; float h0[8], h1[8], h2[8], hv[8], w0[8], w1[8], w2[8], bb[8];
#pragma unroll
            for (int i = 0; i < 8; ++i) { h2[i] = T[row * 64 + c8 + i]; hv[i] = T[row * 64 + 32 + c8 + i]; }
            if (t >= 1) {
#pragma unroll
                for (int i = 0; i < 8; ++i) h1[i] = T[(row - 1) * 64 + c8 + i]; } else ld8(prev + FF + ch, h1);
            if (t >= 2) {
#pragma unroll
                for (int i = 0; i < 8; ++i) h0[i] = T[(row - 2) * 64 + c8 + i]; } else ld8(prev + (size_t)t * FF + ch, h0);
            ld8(cw_ + ch, w0); ld8(cw_ + FF + ch, w1); ld8(cw_ + 2 * FF + ch, w2); ld8(cb_ + ch, bb);
            if (t >= 2) st8(out + O_CS + (size_t)((r >> 2) * 2 + (t - 2)) * FF + ch, h2);
            float o[8];
#pragma unroll
            for (int i = 0; i < 8; ++i) { const float cv = bb[i] + w0[i] * h0[i] + w1[i] * h1[i] + w2[i] * h2[i]; o[i] = cv * ep::sigm(cv) * hv[i]; }
            *(u32x4*)(H + hidx(gr, ch)) = pk8(o); }
    } };
struct Out { const bf16* X2; float* out;
    __device__ __forceinline__ void operator()(int r, int c, float (&v)[8], int) const { float x[8]; ld8bf(X2 + ((size_t)MP + r) * DMODEL + c, x);
#pragma unroll
        for (int i = 0; i < 8; ++i) v[i] += x[i];
        st8(out + O_YS + (size_t)r * DMODEL + c, v); } };
}
#ifndef MK_ONE_LAUNCH
#define MK_ONE_LAUNCH 1
#endif
#ifndef MK_DBL
#define MK_DBL -1
#endif
#define REP(k) for (int rep_ = 0; rep_ < ((MK_DBL == (k)) ? 2 : 1); ++rep_)
#ifndef MK_PH_END
#define MK_PH_END 10
#endif
constexpr int N_PHASES = MK_PH_END;
struct Args { const void* in[N_IN]; float* out; unsigned char* ws; int ph_lo, ph_hi; };
__global__ void __launch_bounds__(512, 2) mk_fwd(Args a) {
    extern __shared__ __attribute__((aligned(16))) unsigned char lds_raw[];
    LAS unsigned char* lds = (LAS unsigned char*)lds_raw;
    const int tid = threadIdx.x, lane = tid & 63, wave = __builtin_amdgcn_readfirstlane(tid >> 6);
    const int G = gridDim.x, bid = blockIdx.x;
    unsigned char* ws = a.ws; float* out = a.out;
    volatile LAS unsigned* MISC = (volatile LAS unsigned*)(lds + MISC_OFF);
    if (tid < 16) MISC[tid] = 0u;
    __syncthreads();
    XcdBarrier bar; bar.bar = (unsigned*)(ws + WS_CTL) + CW_BAR; bar.x = 0; bar.st = nullptr;
    if (MK_ONE_LAUNCH) bar = xcd_barrier_post((unsigned*)(ws + WS_CTL) + CW_BAR, MISC + 8);
#define GRID_BAR() do { if (MK_ONE_LAUNCH) { xcd_barrier(bar); if (MK_DBL == 99) xcd_barrier(bar); } } while (0)
    const int lo = a.ph_lo, hi = a.ph_hi;
#define IN(k) (lo <= (k) && (k) < hi)
#define BOTH(k) (IN(k) && IN((k) + 1))
#define INF(i) ((const float*)a.in[i])
    const int gw = bid * 8 + wave, NGW = G * 8;

    if (IN(0)) REP(0) {
        __syncthreads();
        for (int it = bid; it < NG * 8; it += G)
            ssm_tables(INF(I_ARE), INF(I_AIM), INF(I_BRE), INF(I_BIM), INF(I_CRE), INF(I_CIM), INF(I_D), INF(I_LDT),
                       (bf16*)(ws + WS_TQ), (bf16*)(ws + WS_PM), (float*)(ws + WS_SSMF), it >> 3, it & 7, (LAS float*)lds, tid);
        {
            LAS float* scr = (LAS float*)(lds + wave * 16384);
            constexpr int I_1 = (1024 / 64) * (2048 / 32), I_2 = (1024 / 64) * (1024 / 32), I_3 = (512 / 64) * (512 / 32), I_4 = (1024 / 64) * (FF / 32), I_5 = (FF / 64) * (1024 / 32);
            constexpr int NITEMS = I_1 + 2 * I_2 + I_3 + 3 * I_2 + 2 * I_4 + I_5, NEARLY = I_1 + 2 * I_2 + I_3;
            const int nitems = (G == 256) ? NEARLY : NITEMS;
            for (int it = gw; it < nitems; it += NGW) {
                int r = it;
                if (r < I_1) { transpose_item(INF(I_WIN), 1024, 2048, (bf16*)(ws + WS_WIN), 0, scr, r, lane); continue; } r -= I_1;
                if (r < I_2) { transpose_item(INF(I_WK), 1024, 1024, (bf16*)(ws + WS_WKV), 0, scr, r, lane); continue; } r -= I_2;
                if (r < I_2) { transpose_item(INF(I_WV), 1024, 1024, (bf16*)(ws + WS_WKV), 1024, scr, r, lane); continue; } r -= I_2;
                if (r < I_3) { transpose_item(INF(I_GLU), 512, 512, (bf16*)(ws + WS_GLU), 0, scr, r, lane); continue; } r -= I_3;
                if (r < I_2) { transpose_item(INF(I_WOUT), 1024, 1024, (bf16*)(ws + WS_WOUT), 0, scr, r, lane); continue; } r -= I_2;
                if (r < I_2) { transpose_item(INF(I_WQ), 1024, 1024, (bf16*)(ws + WS_WQ), 0, scr, r, lane, INF(I_LN2)); continue; } r -= I_2;
                if (r < I_2) { transpose_item(INF(I_WO), 1024, 1024, (bf16*)(ws + WS_WO), 0, scr, r, lane); continue; } r -= I_2;
                if (r < I_4) { transpose_item(INF(I_WG), 1024, FF, (bf16*)(ws + WS_WG), 0, scr, r, lane, INF(I_LN3), 1); continue; } r -= I_4;
                if (r < I_4) { transpose_item(INF(I_WVV), 1024, FF, (bf16*)(ws + WS_WG), 0, scr, r, lane, INF(I_LN3), 2); continue; } r -= I_4;
                transpose_item(INF(I_WD), FF, 1024, (bf16*)(ws + WS_WD), 0, scr, r, lane);
            }
        }
        for (int m = gw; m < MTOT + MMEM; m += NGW) {
            if (m < MP) rms_row_to_bf16(INF(I_XP) + (size_t)m * DMODEL, INF(I_LN1), (bf16*)(ws + WS_XN1) + (size_t)m * DMODEL, lane);
            else if (m < MTOT) rms_row_to_bf16(INF(I_XS) + (size_t)(m - MP) * DMODEL, INF(I_LN1), (bf16*)(ws + WS_XN1) + (size_t)m * DMODEL, lane);
            else rms_row_to_bf16(INF(I_MEM) + (size_t)(m - MTOT) * DMODEL, INF(I_MEMG), (bf16*)(ws + WS_MN) + (size_t)(m - MTOT) * DMODEL, lane);
        }
        if (BOTH(0) && rep_ == ((MK_DBL == 0) ? 1 : 0)) GRID_BAR();
    }
#define LATE_TRANSPOSE(NIT, CALL) do { if (G == 256 && bid >= 128) { LAS float* scr = (LAS float*)(lds + wave * 16384); \
        for (int r = (bid - 128) * 8 + wave; r < (NIT); r += 1024) { CALL; } } } while (0)
    if (IN(1)) {
        { pg8::Gemm g{(const bf16*)(ws + WS_XN1), (const bf16*)(ws + WS_WIN), MP, INCOLS, DMODEL}; pg8::StaticOrder S; S.init(MP, INCOLS, G, bid);
          ep::EpiIn E{(bf16*)(ws + WS_UG), (bf16*)(ws + WS_QB), (bf16*)(ws + WS_KB), (bf16*)(ws + WS_VB), out, INF(I_QG), INF(I_KG)};
          pg8::gemm_phase<ep::EpiIn, pg8::StaticOrder, true, true>(lds, g, S, E);
#if MK_DBL == 1
          __syncthreads(); pg8::gemm_phase<ep::EpiIn, pg8::StaticOrder, true, true>(lds, g, S, E);
#endif
          }
        __syncthreads();
        mini_gemm<8>((const bf16*)(ws + WS_XN1) + (size_t)MP * DMODEL, (const bf16*)(ws + WS_WIN), INCOLS, 0, G, bid, lds, tid,
                  mef::In{(bf16*)(ws + WS_UG), (bf16*)(ws + WS_QB), (bf16*)(ws + WS_KB), (bf16*)(ws + WS_VB), out, INF(I_QG), INF(I_KG)});
        if (BOTH(1)) GRID_BAR();
    }
    if (IN(2)) {
        __syncthreads();
        { pg8::Gemm g{(const bf16*)(ws + WS_MN), (const bf16*)(ws + WS_WKV), MMEM, 2048, DMODEL}; pg8::StaticOrder S; S.init(MMEM, 2048, G, (bid + G - G / 2) % G);
          ep::EpiMemKV E{out, (bf16*)(ws + WS_MKB), (bf16*)(ws + WS_MVB), INF(I_CAKG), (LAS float*)(lds + EPI_SCR_OFF)};
          pg8::gemm_phase<ep::EpiMemKV, pg8::StaticOrder, true, true>(lds, g, S, E); }
        __syncthreads();
        __syncthreads();
        for (int it = bid; it < NBATCH * NG; it += G)
            ssm_prompt_item((const bf16*)(ws + WS_UG), (const bf16*)(ws + WS_TQ), (const bf16*)(ws + WS_PM), (const float*)(ws + WS_SSMF), (bf16*)(ws + WS_G), out, it / NG, it % NG, lds, tid);
#if MK_DBL == 20
        for (int it = bid; it < NBATCH * NG; it += G)
            ssm_prompt_item((const bf16*)(ws + WS_UG), (const bf16*)(ws + WS_TQ), (const bf16*)(ws + WS_PM), (const float*)(ws + WS_SSMF), (bf16*)(ws + WS_G), out, it / NG, it % NG, lds, tid);
#endif
        { LAS float* hs = (LAS float*)(lds + wave * 11264); LAS float* Cl = hs + 512; int gcur = -1;
          for (int it = gw; it < NDEC * NG; it += NGW) { const int s_ = it / NG, g_ = it % NG;
              if (g_ != gcur) { gcur = g_;
#pragma unroll
                  for (int q = 0; q < 4; ++q) { const int i4 = lane + 64 * q; *(LAS f32x4*)(Cl + (i4 >> 4) * 68 + 4 * (i4 & 15)) = *(const f32x4*)(INF(I_CRE) + g_ * 1024 + 4 * i4);
                      *(LAS f32x4*)(Cl + 16 * 68 + (i4 >> 4) * 68 + 4 * (i4 & 15)) = *(const f32x4*)(INF(I_CIM) + g_ * 1024 + 4 * i4); }
                  LDS_WAIT(); asm volatile("" ::: "memory"); }
              ssm_sample_item((const bf16*)(ws + WS_UG), (const float*)(ws + WS_SSMF), INF(I_CRE), INF(I_CIM), INF(I_D), INF(I_SRE), INF(I_SIM), (bf16*)(ws + WS_G), out, s_, g_, hs, Cl, lane); } }
        const float smax2 = __builtin_bit_cast(float, __builtin_amdgcn_readfirstlane(__builtin_bit_cast(int, 8.f * wave_max(fabsf(INF(I_QG)[lane])) * wave_max(fabsf(INF(I_KG)[lane])) * LOG2E)));
        __syncthreads();
#pragma unroll 1
        for (int c0_ = bid; c0_ < 256; c0_ += G) {
            const int c = (G == 256) ? (c0_ & 7) * 32 + (c0_ >> 3) : c0_;
            const int grp = c >> 4, j = c & 15, b = grp >> 2, map = (grp >> 1) & 1, vh = grp & 1;
            bf16x8 qrx[4];
#pragma unroll
            for (int d = 0; d < 4; ++d) qrx[d] = bf16x8{};
#pragma unroll 1
            for (int i = 0; i < 4; ++i) { const int h = 3 - i, qb = (i & 1) ? 15 - j : j;
                const float a2 = __builtin_bit_cast(float, __builtin_amdgcn_readfirstlane(__builtin_bit_cast(int, exp2f(-2.f * (float)(h + 1)) * LOG2E)));
                const int W = (int)fminf((2.f * smax2 + 36.f) / a2 + 1.f, 1.0e6f); int t0 = (qb * 256 - W) >> 6; t0 = (t0 < 0 ? 0 : t0) & ~1;
                t0 = __builtin_amdgcn_readfirstlane(t0);
                const size_t qoff = (size_t)(h * 128 + map * 64) * 2, voff = (size_t)(h * 128 + vh * 64) * 2;
                const int hn = i < 3 ? 2 - i : 0, qbn = (i & 1) ? j : 15 - j;
                const float a2n = exp2f(-2.f * (float)(hn + 1)) * LOG2E; const int Wn = (int)fminf((2.f * smax2 + 36.f) / a2n + 1.f, 1.0e6f); int t0n = (qbn * 256 - Wn) >> 6; t0n = (t0n < 0 ? 0 : t0n) & ~1;
                t0n = __builtin_amdgcn_readfirstlane(t0n);
                const size_t qoffn = (size_t)(hn * 128 + map * 64) * 2;
#ifndef NO_ATTN
                attn_body::attn_unit<60>(b, qb, (const attn_body::bf16*)(ws + WS_QB + qoff), (const attn_body::bf16*)(ws + WS_KB + qoff), (const attn_body::bf16*)(ws + WS_VB + voff),
                                        (attn_body::bf16*)(ws + (map ? WS_O1 : WS_O0) + voff), (char*)lds_raw, a2, t0, smax2 * 1.01f + 0.25f,
                                        qrx, i > 0, i < 3, qbn, (const attn_body::bf16*)(ws + WS_QB + qoffn), (const attn_body::bf16*)(ws + WS_KB + qoffn), t0n);
#endif
            }
        }
#if MK_DBL == 21
#pragma unroll 1
        for (int c0_ = bid; c0_ < 256; c0_ += G) {
            const int c = (G == 256) ? (c0_ & 7) * 32 + (c0_ >> 3) : c0_;
            const int grp = c >> 4, j = c & 15, b = grp >> 2, map = (grp >> 1) & 1, vh = grp & 1;
            bf16x8 qrx[4];
#pragma unroll
            for (int d = 0; d < 4; ++d) qrx[d] = bf16x8{};
#pragma unroll 1
            for (int i = 0; i < 4; ++i) { const int h = 3 - i, qb = (i & 1) ? 15 - j : j;
                const float a2 = __builtin_bit_cast(float, __builtin_amdgcn_readfirstlane(__builtin_bit_cast(int, exp2f(-2.f * (float)(h + 1)) * LOG2E)));
                const int W = (int)fminf((2.f * smax2 + 36.f) / a2 + 1.f, 1.0e6f); int t0 = (qb * 256 - W) >> 6; t0 = (t0 < 0 ? 0 : t0) & ~1;
                t0 = __builtin_amdgcn_readfirstlane(t0);
                const size_t qoff = (size_t)(h * 128 + map * 64) * 2, voff = (size_t)(h * 128 + vh * 64) * 2;
                const int hn = i < 3 ? 2 - i : 0, qbn = (i & 1) ? j : 15 - j;
                const float a2n = exp2f(-2.f * (float)(hn + 1)) * LOG2E; const int Wn = (int)fminf((2.f * smax2 + 36.f) / a2n + 1.f, 1.0e6f); int t0n = (qbn * 256 - Wn) >> 6; t0n = (t0n < 0 ? 0 : t0n) & ~1;
                t0n = __builtin_amdgcn_readfirstlane(t0n);
                const size_t qoffn = (size_t)(hn * 128 + map * 64) * 2;
#ifndef NO_ATTN
                attn_body::attn_unit<60>(b, qb, (const attn_body::bf16*)(ws + WS_QB + qoff), (const attn_body::bf16*)(ws + WS_KB + qoff), (const attn_body::bf16*)(ws + WS_VB + voff),
                                        (attn_body::bf16*)(ws + (map ? WS_O1 : WS_O0) + voff), (char*)lds_raw, a2, t0, smax2 * 1.01f + 0.25f,
                                        qrx, i > 0, i < 3, qbn, (const attn_body::bf16*)(ws + WS_QB + qoffn), (const attn_body::bf16*)(ws + WS_KB + qoffn), t0n);
#endif
            }
        }
#endif
        __syncthreads();
        { const float lam = __builtin_bit_cast(float, __builtin_amdgcn_readfirstlane(__builtin_bit_cast(int, lam_value(INF(I_LQ1), INF(I_LK1), INF(I_LQ2), INF(I_LK2), lane))));
          unsigned* qctr = (unsigned*)(ws + WS_CTL) + CW_QUEUE; volatile LAS int* qslot = (volatile LAS int*)(MISC);
#pragma unroll 1
          for (;;) {
              __syncthreads();
              if (tid == 0) qslot[0] = (int)atomicAdd(qctr, 1u);
              __syncthreads();
              const int u_ = __builtin_amdgcn_readfirstlane(qslot[0]);
              if (u_ >= NDEC * NH * ((MK_DBL == 22) ? 2 : 1)) break;
              const int u = u_ & (NDEC * NH - 1);
              const int h = 3 - (u >> 7), s = u & 127;
              const float a2 = exp2f(-2.f * (float)(h + 1)) * LOG2E; const int W = (int)fminf((2.f * smax2 + 36.f) / a2 + 1.f, 1.0e6f);
              int c0 = (PAST - W) >> 6; c0 = __builtin_amdgcn_readfirstlane(c0 < 0 ? 0 : c0);
#ifndef NO_SATTN
              sattn_unit((const bf16*)(ws + WS_QB), (const bf16*)(ws + WS_KB), (const bf16*)(ws + WS_VB), INF(I_CK), INF(I_CV), (const int*)a.in[I_PT], (bf16*)(ws + WS_MIX), INF(I_SUBLN), lam, s, h, c0, lds, tid);
#endif
          } }
        if (BOTH(2)) GRID_BAR();
    }
    if (IN(3)) {
        if (G == 256 && bid >= 128 && (bid < 160 || bid >= 224)) {
            __syncthreads(); LAS float* scr = (LAS float*)(lds + wave * 16384); const int wv = ((bid < 160 ? bid - 128 : bid - 192)) * 8 + wave;
            for (int r = wv; r < 2 * (1024 / 64) * (1024 / 32); r += 512) {
                if (r < 512) transpose_item(INF(I_WOUT), 1024, 1024, (bf16*)(ws + WS_WOUT), 0, scr, r, lane);
                else transpose_item(INF(I_WQ), 1024, 1024, (bf16*)(ws + WS_WQ), 0, scr, r - 512, lane, INF(I_LN2)); }
            __syncthreads(); }
        { const float lam = lam_value(INF(I_LQ1), INF(I_LK1), INF(I_LQ2), INF(I_LK2), lane);
          int m0, m1, cw0, ncw;
          if (G == 256) { const bool glu = bid < 128; m0 = glu ? 0 : 5120; m1 = glu ? 5120 : MP; cw0 = (glu ? bid : bid - 128) * 8 + wave; ncw = 1024; } else { m0 = 0; m1 = MP; cw0 = gw; ncw = NGW; }
          { int m = m0 + cw0;
              for (; m + 3 * ncw < m1; m += 4 * ncw) combine_rows<4>((const bf16*)(ws + WS_O0), (const bf16*)(ws + WS_O1), (bf16*)(ws + WS_MIX), INF(I_SUBLN), lam, m, ncw, lane);
              for (; m < m1; m += ncw) combine_rows<1>((const bf16*)(ws + WS_O0), (const bf16*)(ws + WS_O1), (bf16*)(ws + WS_MIX), INF(I_SUBLN), lam, m, ncw, lane); } }
        { pg8::Gemm g{(const bf16*)(ws + WS_G), (const bf16*)(ws + WS_GLU), MP, 512, 512}; pg8::StaticOrder S; S.init(MP, 512, G, bid);
          ep::EpiGlu E{(const bf16*)(ws + WS_G), (bf16*)(ws + WS_MIX)};
          pg8::gemm_phase<ep::EpiGlu, pg8::StaticOrder, true, true>(lds, g, S, E);
#if MK_DBL == 3
          __syncthreads(); pg8::gemm_phase<ep::EpiGlu, pg8::StaticOrder, true, true>(lds, g, S, E);
#endif
          }
        __syncthreads();
        mini_gemm<4>((const bf16*)(ws + WS_G) + (size_t)MP * 512, (const bf16*)(ws + WS_GLU), 512, (G >= 256 ? 160 : 0), (G >= 256 ? 64 : G), bid, lds, tid, mef::Glu{(const bf16*)(ws + WS_G), (bf16*)(ws + WS_MIX)});
        if (BOTH(3)) GRID_BAR();
    }
    if (IN(4)) {
        __syncthreads();
        LATE_TRANSPOSE((FF / 64) * (1024 / 32), transpose_item(INF(I_WD), FF, 1024, (bf16*)(ws + WS_WD), 0, scr, r, lane));
        mini_gemm<8>((const bf16*)(ws + WS_MIX) + (size_t)MP * DMODEL, (const bf16*)(ws + WS_WOUT), DMODEL, 0, G, bid, lds, tid,
                  mef::Res<false>{INF(I_XS), (bf16*)(ws + WS_XB1), (float*)(ws + WS_SS1)});
        __syncthreads();
        pg8::Gemm g{(const bf16*)(ws + WS_MIX), (const bf16*)(ws + WS_WOUT), MP, DMODEL, DMODEL}; pg8::StaticOrder S; S.init(MP, DMODEL, G, bid);
        ep::EpiRes<false> E{INF(I_XP), (bf16*)(ws + WS_XB1), (float*)(ws + WS_SS1)};
        pg8::gemm_phase<ep::EpiRes<false>, pg8::StaticOrder, true, true>(lds, g, S, E);
#if MK_DBL == 4
        __syncthreads(); pg8::gemm_phase<ep::EpiRes<false>, pg8::StaticOrder, true, true>(lds, g, S, E);
#endif
        if (BOTH(4)) GRID_BAR();
    }
    if (IN(5)) {
        __syncthreads();
        LATE_TRANSPOSE((1024 / 64) * (1024 / 32), transpose_item(INF(I_WO), 1024, 1024, (bf16*)(ws + WS_WO), 0, scr, r, lane));
        LATE_TRANSPOSE((1024 / 64) * (FF / 32), transpose_item(INF(I_WG), 1024, FF, (bf16*)(ws + WS_WG), 0, scr, r, lane, INF(I_LN3), 1));
        mini_gemm<8>((const bf16*)(ws + WS_XB1) + (size_t)MP * DMODEL, (const bf16*)(ws + WS_WQ), DMODEL, 0, G, bid, lds, tid,
                  mef::Cq{(const float*)(ws + WS_SS1), (bf16*)(ws + WS_CQ), (float*)(ws + WS_SSQ), INF(I_CAQG)});
        __syncthreads();
        pg8::Gemm g{(const bf16*)(ws + WS_XB1), (const bf16*)(ws + WS_WQ), MP, DMODEL, DMODEL}; pg8::StaticOrder S; S.init(MP, DMODEL, G, bid);
        ep::EpiCq E{(const float*)(ws + WS_SS1), (bf16*)(ws + WS_CQ), INF(I_CAQG), (LAS float*)(lds + EPI_SCR_OFF), (LAS float*)(lds + EPI_RS_OFF)};
        pg8::gemm_phase<ep::EpiCq, pg8::StaticOrder, true, true>(lds, g, S, E);
#if MK_DBL == 5
        __syncthreads(); pg8::gemm_phase<ep::EpiCq, pg8::StaticOrder, true, true>(lds, g, S, E);
#endif
        if (BOTH(5)) GRID_BAR();
    }
    if (IN(6)) {
        __syncthreads();
        float xmref; { float gq = 0.f, gk = 0.f;
#pragma unroll
            for (int i = 0; i < 4; ++i) { gq = fmaxf(gq, fabsf(INF(I_CAQG)[lane + 64 * i])); gk = fmaxf(gk, fabsf(INF(I_CAKG)[lane + 64 * i])); }
            xmref = __builtin_bit_cast(float, __builtin_amdgcn_readfirstlane(__builtin_bit_cast(int, 16.f * wave_max(gq) * wave_max(gk) * LOG2E * 1.01f + 0.25f))); }
#pragma unroll 1
        for (int k = 0; k < 2 * ((512 + G - 1) / G); ++k) { const int it = k >> 1, u = bid + it * G; if (u >= 512) break;
            if (((k ^ (bid >> 3)) & 1) == 0) xattn_prompt_unit2((const bf16*)(ws + WS_CQ), (const bf16*)(ws + WS_MKB), (const bf16*)(ws + WS_MVB), (bf16*)(ws + WS_CO), u >> 2, u & 3, xmref, lds, tid);
            else xattn_sample_unit((const bf16*)(ws + WS_CQ), (const float*)(ws + WS_SSQ), INF(I_CMK), INF(I_CMV), (bf16*)(ws + WS_CO), u >> 2, u & 3, lds, tid);
        }
#if MK_DBL == 12
#pragma unroll 1
        for (int u = bid; u < 512; u += G) xattn_sample_unit((const bf16*)(ws + WS_CQ), (const float*)(ws + WS_SSQ), INF(I_CMK), INF(I_CMV), (bf16*)(ws + WS_CO), u >> 2, u & 3, lds, tid);
#endif
#if MK_DBL == 13
#pragma unroll 1
        for (int u = bid; u < 512; u += G) xattn_prompt_unit2((const bf16*)(ws + WS_CQ), (const bf16*)(ws + WS_MKB), (const bf16*)(ws + WS_MVB), (bf16*)(ws + WS_CO), u >> 2, u & 3, xmref, lds, tid);
#endif
#if MK_DBL == 6
#pragma unroll 1
        for (int k = 0; k < 2 * ((512 + G - 1) / G); ++k) { const int it = k >> 1, u = bid + it * G; if (u >= 512) break;
            if (((k ^ (bid >> 3)) & 1) == 0) xattn_prompt_unit2((const bf16*)(ws + WS_CQ), (const bf16*)(ws + WS_MKB), (const bf16*)(ws + WS_MVB), (bf16*)(ws + WS_CO), u >> 2, u & 3, xmref, lds, tid);
            else xattn_sample_unit((const bf16*)(ws + WS_CQ), (const float*)(ws + WS_SSQ), INF(I_CMK), INF(I_CMV), (bf16*)(ws + WS_CO), u >> 2, u & 3, lds, tid);
        }
#endif
        if (BOTH(6)) GRID_BAR();
    }
    if (IN(7)) {
        __syncthreads();
        LATE_TRANSPOSE((1024 / 64) * (FF / 32), transpose_item(INF(I_WVV), 1024, FF, (bf16*)(ws + WS_WG), 0, scr, r, lane, INF(I_LN3), 2));
        mini_gemm<8>((const bf16*)(ws + WS_CO) + (size_t)MP * DMODEL, (const bf16*)(ws + WS_WO), DMODEL, 0, G, bid, lds, tid,
                  mef::Res<true>{(const bf16*)(ws + WS_XB1) + (size_t)MP * DMODEL, (bf16*)(ws + WS_XB2), (float*)(ws + WS_SS2)});
        __syncthreads();
        pg8::Gemm g{(const bf16*)(ws + WS_CO), (const bf16*)(ws + WS_WO), MP, DMODEL, DMODEL}; pg8::StaticOrder S; S.init(MP, DMODEL, G, bid);
        ep::EpiRes<true> E{(const bf16*)(ws + WS_XB1), (bf16*)(ws + WS_XB2), (float*)(ws + WS_SS2)};
        pg8::gemm_phase<ep::EpiRes<true>, pg8::StaticOrder, true, true>(lds, g, S, E);
#if MK_DBL == 7
        __syncthreads(); pg8::gemm_phase<ep::EpiRes<true>, pg8::StaticOrder, true, true>(lds, g, S, E);
#endif
        if (BOTH(7)) GRID_BAR();
    }
    if (IN(8)) {
        __syncthreads();
#pragma unroll 1
        for (int run = bid; run < ep::FFN_RUNS; run += G) {
            ep::RunOrder S; S.init(run);
            ep::ffn_carry_init((const bf16*)(ws + WS_XB2), (const bf16*)(ws + WS_WG), (const float*)(ws + WS_SS2), S.pm0, S.pn, (LAS float*)(lds + EPI_HALO_OFF), tid);
            pg8::Gemm g{(const bf16*)(ws + WS_XB2), (const bf16*)(ws + WS_WG), MP, 2 * FF, DMODEL};
            ep::EpiFfn E{(const float*)(ws + WS_SS2), (bf16*)(ws + WS_H), out, INF(I_CONVW), INF(I_CONVB), (LAS float*)(lds + EPI_RS_OFF), (LAS float*)(lds + EPI_HALO_OFF)};
            pg8::gemm_phase<ep::EpiFfn, ep::RunOrder, true, true>(lds, g, S, E);
            __syncthreads();
        }
#if MK_DBL == 8
#pragma unroll 1
        for (int run = bid; run < ep::FFN_RUNS; run += G) {
            ep::RunOrder S; S.init(run);
            ep::ffn_carry_init((const bf16*)(ws + WS_XB2), (const bf16*)(ws + WS_WG), (const float*)(ws + WS_SS2), S.pm0, S.pn, (LAS float*)(lds + EPI_HALO_OFF), tid);
            pg8::Gemm g{(const bf16*)(ws + WS_XB2), (const bf16*)(ws + WS_WG), MP, 2 * FF, DMODEL};
            ep::EpiFfn E{(const float*)(ws + WS_SS2), (bf16*)(ws + WS_H), out, INF(I_CONVW), INF(I_CONVB), (LAS float*)(lds + EPI_RS_OFF), (LAS float*)(lds + EPI_HALO_OFF)};
            pg8::gemm_phase<ep::EpiFfn, ep::RunOrder, true, true>(lds, g, S, E);
            __syncthreads();
        }
#endif
        mini_gemm<8, false, true>((const bf16*)(ws + WS_XB2) + (size_t)MP * DMODEL, (const bf16*)(ws + WS_WG), 2 * FF, 0, G, bid, lds, tid,
                  mef::Ffn{(const float*)(ws + WS_SS2), (bf16*)(ws + WS_H), out, INF(I_CONVW), INF(I_CONVB), INF(I_SCONV)},
                  (unsigned*)(ws + WS_CTL) + CW_QUEUE2, (volatile LAS int*)(MISC));
        if (BOTH(8)) GRID_BAR();
    }
    if (IN(9)) {
        __syncthreads();
        mini_gemm<22, true, false, true>((const bf16*)(ws + WS_H), (const bf16*)(ws + WS_WD), DMODEL, 0, G, bid, lds, tid, mef::Out{(const bf16*)(ws + WS_XB2), out});
#if MK_DBL == 11
        __syncthreads();
        mini_gemm<22, true, false, true>((const bf16*)(ws + WS_H), (const bf16*)(ws + WS_WD), DMODEL, 0, G, bid, lds, tid, mef::Out{(const bf16*)(ws + WS_XB2), out});
#endif
        __syncthreads();
        pg8::Gemm g{(const bf16*)(ws + WS_H), (const bf16*)(ws + WS_WD), MP, DMODEL, FF, 64, (size_t)MTOT * 128}; pg8::StaticOrder S; S.init(MP, DMODEL, G, bid);
        ep::EpiOut E{(const bf16*)(ws + WS_XB2), out};
        pg8::gemm_phase<ep::EpiOut, pg8::StaticOrder, true, true>(lds, g, S, E);
#if MK_DBL == 10
        __syncthreads(); pg8::gemm_phase<ep::EpiOut, pg8::StaticOrder, true, true>(lds, g, S, E);
#endif
    }
#undef IN
#undef BOTH
}

extern "C" void kernel_launch(void* const* d_in, const int* in_sizes, int n_in, void* d_out, int out_size, void* d_ws, size_t ws_size, hipStream_t stream) {
    static int grid = 0;
    if (grid == 0) {
        if (n_in != N_IN || (size_t)out_size != O_END || ws_size < WS_END) { fprintf(stderr, "kernel_launch: unexpected sizes n_in %d out %d ws %zu (need %zu)\n", n_in, out_size, ws_size, (size_t)WS_END); grid = -1; return; }
        int dev = 0, cus = 0;
        if (hipGetDevice(&dev) != hipSuccess || hipDeviceGetAttribute(&cus, hipDeviceAttributeMultiprocessorCount, dev) != hipSuccess) { grid = -1; return; }
        if (hipFuncSetAttribute((const void*)mk_fwd, hipFuncAttributeMaxDynamicSharedMemorySize, LDS_BYTES) != hipSuccess) { fprintf(stderr, "kernel_launch: hipFuncSetAttribute failed\n"); grid = -1; return; }
        int per_cu = 0;
        if (hipOccupancyMaxActiveBlocksPerMultiprocessor(&per_cu, (const void*)mk_fwd, 512, LDS_BYTES) != hipSuccess || per_cu < 1) fprintf(stderr, "kernel_launch: occupancy query says %d\n", per_cu);
        (void)hipGetLastError();
        grid = cus;
    }
    if (grid < 0) return;
    (void)hipMemsetAsync((char*)d_ws + WS_CTL, 0, CTL_ZERO_BYTES, stream);
#if MK_PH_END < 10
    (void)hipMemsetAsync(d_out, 0, (size_t)out_size * 4, stream);
#endif
    Args a{};
    for (int i = 0; i < N_IN; ++i) a.in[i] = d_in[i];
    a.out = (float*)d_out; a.ws = (unsigned char*)d_ws;
#if MK_ONE_LAUNCH
    a.ph_lo = 0; a.ph_hi = N_PHASES;
    hipLaunchKernelGGL(mk_fwd, dim3(grid), dim3(512), LDS_BYTES, stream, a);
#else
    for (int p = 0; p < N_PHASES; ++p) { a.ph_lo = p; a.ph_hi = p + 1; hipLaunchKernelGGL(mk_fwd, dim3(grid), dim3(512), LDS_BYTES, stream, a); }
#endif
}
```

```cpp
#include <hip/hip_runtime.h>
#include <cstdio>
#include <cstdint>
#include <cmath>
#include <hip/hip_bf16.h>
#define DBG_KV 1.0f
#define DBG_MKV 1.0f
#define DBG_SSM 1.0f
#define DBG_CONV 1.0f
#define DBG_Y 1.0f
namespace pg8 {
#define PG8_LAS __attribute__((address_space(3)))
typedef unsigned short bf16_t;
typedef short bf16x8 __attribute__((ext_vector_type(8)));
typedef float f32x4 __attribute__((ext_vector_type(4)));
typedef unsigned u32x4 __attribute__((ext_vector_type(4)));
constexpr int BM = 256, BK = 64, HALF = 128, HTB = HALF * BK * 2  , STAGE_BYTES = 8 * HTB, NXCD = 8, WGM = 8;

__host__ __device__ __forceinline__ int lds_byte(int r, int c) { const int st = (r >> 4) * 2 + (c >> 5), rr = r & 15, cc = c & 31, ob = rr * 64 + cc * 2; return st * 1024 + (ob ^ (((ob >> 9) & 1) << 5)); }
__host__ __device__ __forceinline__ void stage_rc(int b, int& R, int& C) { const int st = b / 1024, sb = b % 1024, swz = sb ^ (((sb >> 9) & 1) << 5); R = (st >> 1) * 16 + swz / 64; C = (st & 1) * 32 + (swz % 64) / 2; }
__host__ __device__ __forceinline__ int perm32(int rho) { const int n = rho >> 4, i = rho & 15; return 8 * (i >> 2) + 4 * n + (i & 3); }

struct Unit { int pm, pn; };
struct Gemm { const bf16_t* A; const bf16_t* Bt; int M, N, K; int lda = 0; size_t akstep = 0; };

struct StaticOrder {
    int nM, nN, nwg, G, c;
    __host__ __device__ void init(int M, int N, int G_, int c_) { nM = M / BM; nN = N / BM; nwg = nM * nN; G = G_; c = c_; }
    __host__ __device__ bool next(int i, Unit& u) const {
        const long L = (long)i * G + c; if (L >= nwg) return false;
        int wgid = (int)L; { const int q = nwg / NXCD, r = nwg % NXCD, xcd = wgid % NXCD, off = wgid / NXCD; wgid = (xcd < r ? xcd * (q + 1) : r * (q + 1) + (xcd - r) * q) + off; }
        const int nig = WGM * nN, gid = wgid / nig, fm = gid * WGM, gsz = (nM - fm) < WGM ? (nM - fm) : WGM;
        u.pm = fm + ((wgid % nig) % gsz); u.pn = (wgid % nig) / gsz; return true;
    }
    __device__ __forceinline__ void a_ready(const Unit&) const {}
    __device__ __forceinline__ void done(const Unit&) const {}
};

typedef float f32x2cv __attribute__((ext_vector_type(2))); typedef __bf16 bf16x2cv __attribute__((ext_vector_type(2)));
__device__ __forceinline__ unsigned cvt_pk_bf16(float lo, float hi) { const f32x2cv v = {lo, hi}; return __builtin_bit_cast(unsigned, __builtin_convertvector(v, bf16x2cv)); }
template <class Epi, class Sched, bool ALIGN_EPI = false, bool SP2 = false>
__device__ __forceinline__ void gemm_phase(PG8_LAS unsigned char* lds, const Gemm g, const Sched& S, const Epi& E) {
    const int tid = threadIdx.x, wid = __builtin_amdgcn_readfirstlane(tid >> 6), lane = tid & 63, wr = wid >> 2, wc = wid & 3, fr = lane & 15, fq = lane >> 4;
    const int K = g.K, nt = K / BK, lda = g.lda ? g.lda : K;
    unsigned voffA[2], voffB[2];
#pragma unroll
    for (int i = 0; i < 2; ++i) { int R, C; stage_rc(tid * 16 + i * 8192, R, C); const int Rb = Epi::PERM ? ((R & ~31) + perm32(R & 31)) : R;
        voffA[i] = (unsigned)(R * lda + C) * 2u; voffB[i] = (unsigned)(Rb * K + C) * 2u; }
    const size_t akstep = g.akstep ? g.akstep : (size_t)(BK * 2), ahstep = (size_t)HALF * lda * 2, atstep = 2 * ahstep;
    const size_t kstep = (size_t)(BK * 2);
    const size_t hstep = (size_t)HALF * K * 2;
    const size_t tstep = 2 * hstep;
    const unsigned ldsw = (unsigned)wid * 1024u;
    const int aoff = lds_byte(wr * 64 + fr, fq * 8), boff = lds_byte(wc * 32 + fr, fq * 8);
#define PG8_SA(b, h) (((b) * 2 + (h)) * HTB)
#define PG8_SB(b, h) ((4 + (b) * 2 + (h)) * HTB)
#define PG8_STAGE(bufoff, gbase, voff) do { _Pragma("unroll") for (int _i = 0; _i < 2; ++_i) \
        __builtin_amdgcn_global_load_lds((const unsigned*)((const char*)(gbase) + (voff)[_i]), (PG8_LAS unsigned*)(lds + (bufoff) + ldsw + _i * 8192), 16, 0, 0); } while (0)
#define PG8_LDA(dst, b, h) do { _Pragma("unroll") for (int m = 0; m < 4; ++m) _Pragma("unroll") for (int k = 0; k < 2; ++k) dst[m][k] = *(const PG8_LAS bf16x8*)(lds + PG8_SA(b, h) + aoff + m * 2048 + k * 1024); } while (0)
#define PG8_LDB(dst, b, h) do { _Pragma("unroll") for (int n = 0; n < 2; ++n) _Pragma("unroll") for (int k = 0; k < 2; ++k) dst[n][k] = *(const PG8_LAS bf16x8*)(lds + PG8_SB(b, h) + boff + n * 2048 + k * 1024); } while (0)
#define PG8_MMA(ai, bj, At, Bt) do { __builtin_amdgcn_s_setprio(1); _Pragma("unroll") for (int m = 0; m < 4; ++m) _Pragma("unroll") for (int n = 0; n < 2; ++n) _Pragma("unroll") for (int k = 0; k < 2; ++k) \
        acc[ai][bj][m][n] = __builtin_amdgcn_mfma_f32_16x16x32_bf16(Bt[n][k], At[m][k], acc[ai][bj][m][n], 0, 0, 0); __builtin_amdgcn_s_setprio(0); } while (0)
#define PG8_WAIT_V(n) asm volatile("s_waitcnt vmcnt(" #n ")" ::: "memory")
#define PG8_WAIT_L(n) asm volatile("s_waitcnt lgkmcnt(" #n ")" ::: "memory")
#define PG8_BAR __builtin_amdgcn_s_barrier()
#define PG8_SCHED __builtin_amdgcn_sched_barrier(0)
    Unit cur, nxt; int ui = 0;
    if (!S.next(0, cur)) return;
    f32x4 acc[2][2][4][2];
#pragma unroll
    for (int a = 0; a < 2; ++a)
#pragma unroll
        for (int b = 0; b < 2; ++b)
#pragma unroll
            for (int m = 0; m < 4; ++m)
#pragma unroll
                for (int n = 0; n < 2; ++n) acc[a][b][m][n] = (f32x4){0.f, 0.f, 0.f, 0.f};
    bf16x8 At[4][2], B0[2][2], B1[2][2];
    const char* cA = (const char*)g.A + (size_t)cur.pm * atstep; const char* cB = (const char*)g.Bt + (size_t)cur.pn * tstep;
    S.a_ready(cur);
    if constexpr (SP2) {
        PG8_STAGE(PG8_SB(0, 0), cB, voffB); PG8_STAGE(PG8_SB(0, 1), cB + hstep, voffB); PG8_STAGE(PG8_SA(0, 0), cA, voffA); PG8_STAGE(PG8_SA(0, 1), cA + ahstep, voffA);
        if (wr == 1) PG8_BAR;
        PG8_WAIT_V(2); PG8_BAR;
        PG8_STAGE(PG8_SB(1, 0), cB + kstep, voffB); PG8_STAGE(PG8_SA(1, 0), cA + akstep, voffA); PG8_STAGE(PG8_SB(1, 1), cB + hstep + kstep, voffB);
        PG8_WAIT_V(6); PG8_BAR;
    } else {
        PG8_STAGE(PG8_SB(0, 0), cB, voffB); PG8_STAGE(PG8_SA(0, 0), cA, voffA); PG8_STAGE(PG8_SB(0, 1), cB + hstep, voffB); PG8_STAGE(PG8_SA(0, 1), cA + ahstep, voffA);
        if (wr == 1) PG8_BAR;
        PG8_WAIT_V(4); PG8_BAR;
        PG8_STAGE(PG8_SB(1, 0), cB + kstep, voffB); PG8_STAGE(PG8_SA(1, 0), cA + akstep, voffA); PG8_STAGE(PG8_SB(1, 1), cB + hstep + kstep, voffB);
        PG8_WAIT_V(6); PG8_BAR;
    }
    for (;;) {
        const bool has_next = S.next(ui + 1, nxt);
        const char* nA = has_next ? (const char*)g.A + (size_t)nxt.pm * atstep : cA; const char* nB = has_next ? (const char*)g.Bt + (size_t)nxt.pn * tstep : cB;
        for (int t = 0; t < nt; t += 2) {
            const bool last = (t == nt - 2);
            const char* a1 = cA + (size_t)(t + 1) * akstep;
            const char* a2 = last ? nA : cA + (size_t)(t + 2) * akstep; const char* b2 = last ? nB : cB + (size_t)(t + 2) * kstep;
            const char* a3 = a2 + akstep; const char* b3 = b2 + kstep;
            if (last && has_next) S.a_ready(nxt);
            if constexpr (SP2) {
            PG8_LDB(B0, 0, 0); PG8_LDB(B1, 0, 1); PG8_SCHED; PG8_LDA(At, 0, 0); PG8_STAGE(PG8_SA(1, 1), a1 + ahstep, voffA);
            PG8_WAIT_V(8); PG8_WAIT_L(0); PG8_BAR; PG8_MMA(0, 0, At, B0); PG8_MMA(0, 1, At, B1); PG8_BAR; PG8_SCHED;
            PG8_LDA(At, 0, 1); PG8_STAGE(PG8_SB(0, 0), b2, voffB); PG8_STAGE(PG8_SB(0, 1), b2 + hstep, voffB); PG8_STAGE(PG8_SA(0, 0), a2, voffA);
            PG8_WAIT_V(8); PG8_WAIT_L(0); PG8_BAR; PG8_MMA(1, 0, At, B0); PG8_MMA(1, 1, At, B1); PG8_BAR; PG8_SCHED;
            PG8_LDB(B0, 1, 0); PG8_LDB(B1, 1, 1); PG8_SCHED; PG8_LDA(At, 1, 0); PG8_STAGE(PG8_SA(0, 1), a2 + ahstep, voffA);
            PG8_WAIT_V(8); PG8_WAIT_L(0); PG8_BAR; PG8_MMA(0, 0, At, B0); PG8_MMA(0, 1, At, B1); PG8_BAR; PG8_SCHED;
            PG8_LDA(At, 1, 1); PG8_STAGE(PG8_SB(1, 0), b3, voffB); PG8_STAGE(PG8_SB(1, 1), b3 + hstep, voffB); PG8_STAGE(PG8_SA(1, 0), a3, voffA);
            PG8_WAIT_V(8); PG8_WAIT_L(0); PG8_BAR; PG8_MMA(1, 0, At, B0); PG8_MMA(1, 1, At, B1); PG8_BAR; PG8_SCHED;
            } else {
            PG8_LDB(B0, 0, 0); PG8_SCHED; PG8_LDA(At, 0, 0); PG8_STAGE(PG8_SA(1, 1), a1 + ahstep, voffA);
            PG8_WAIT_L(8); PG8_BAR; PG8_WAIT_L(0); PG8_MMA(0, 0, At, B0); PG8_BAR; PG8_SCHED;
            PG8_LDB(B1, 0, 1); PG8_STAGE(PG8_SB(0, 0), b2, voffB);
            PG8_BAR; PG8_WAIT_L(0); PG8_MMA(0, 1, At, B1); PG8_BAR;
            PG8_LDA(At, 0, 1); PG8_STAGE(PG8_SA(0, 0), a2, voffA);
            PG8_BAR; PG8_WAIT_L(0); PG8_MMA(1, 0, At, B0); PG8_BAR; PG8_SCHED;
            PG8_STAGE(PG8_SB(0, 1), b2 + hstep, voffB);
            PG8_WAIT_V(6); PG8_BAR; PG8_MMA(1, 1, At, B1); PG8_BAR;
            PG8_LDB(B0, 1, 0); PG8_SCHED; PG8_LDA(At, 1, 0); PG8_STAGE(PG8_SA(0, 1), a2 + ahstep, voffA);
            PG8_WAIT_L(8); PG8_BAR; PG8_WAIT_L(0); PG8_MMA(0, 0, At, B0); PG8_BAR; PG8_SCHED;
            PG8_LDB(B1, 1, 1); PG8_STAGE(PG8_SB(1, 0), b3, voffB);
            PG8_BAR; PG8_WAIT_L(0); PG8_MMA(0, 1, At, B1); PG8_BAR;
            PG8_LDA(At, 1, 1); PG8_STAGE(PG8_SA(1, 0), a3, voffA);
            PG8_BAR; PG8_WAIT_L(0); PG8_MMA(1, 0, At, B0); PG8_BAR; PG8_SCHED;
            PG8_STAGE(PG8_SB(1, 1), b3 + hstep, voffB);
            PG8_WAIT_V(6); PG8_BAR; PG8_MMA(1, 1, At, B1); PG8_BAR;
            }
        }
        if constexpr (ALIGN_EPI) { if (wr == 0) PG8_BAR; }
        if constexpr (!Epi::AFTER_DRAIN) { E(acc, cur, wr, wc, fr, fq); S.done(cur); }
        if (!has_next) break;
#pragma unroll
        for (int a = 0; a < 2; ++a)
#pragma unroll
            for (int b = 0; b < 2; ++b)
#pragma unroll
                for (int m = 0; m < 4; ++m)
#pragma unroll
                    for (int n = 0; n < 2; ++n) acc[a][b][m][n] = (f32x4){0.f, 0.f, 0.f, 0.f};
        cur = nxt; cA = nA; cB = nB; ++ui;
        if constexpr (ALIGN_EPI) { if (wr == 1) PG8_BAR; }
    }
    PG8_WAIT_V(0);
    if constexpr (!ALIGN_EPI) { if (wr == 0) PG8_BAR; }
    PG8_BAR;
    if constexpr (Epi::AFTER_DRAIN) { E.fused(acc, cur, wr, wc, fr, fq, lds, wid, lane); S.done(cur); }
#undef PG8_SA
#undef PG8_SB
#undef PG8_STAGE
#undef PG8_LDA
#undef PG8_LDB
#undef PG8_MMA
#undef PG8_WAIT_V
#undef PG8_WAIT_L
#undef PG8_BAR
#undef PG8_SCHED
}
}
#define LAS __attribute__((address_space(3)))
#define GAS __attribute__((address_space(1)))
typedef unsigned short bf16;
typedef short bf16x8 __attribute__((ext_vector_type(8)));
typedef float f32x4 __attribute__((ext_vector_type(4)));
typedef float f32x2 __attribute__((ext_vector_type(2)));
typedef float f32x16 __attribute__((ext_vector_type(16)));
typedef unsigned u32x4 __attribute__((ext_vector_type(4)));
typedef unsigned u32x2 __attribute__((ext_vector_type(2)));
typedef GAS unsigned gu32;

constexpr int DMODEL = 1024, NBATCH = 4, SEQ = 4096, MP = NBATCH * SEQ, NDEC = 128, DSEQ = 4, MS = NDEC * DSEQ, MTOT = MP + MS;
constexpr int PAST = 2048, PAGE = 128, NPAGES = PAST / PAGE;
constexpr int NG = 32, GC = 16, NST = 64, SSMW = 512, ATW = 512, NH = 4, HD = 64, VD = 128, INCOLS = 2048;
constexpr int NMEM = 256, CAH = 4, CAD = 256, MMEM = NBATCH * NMEM;
constexpr int FF = 2816;
constexpr float EPS = 1e-6f;
constexpr float LOG2E = 1.4426950408889634f;
constexpr float C2 = 0.125f * LOG2E;
constexpr float CA2 = 0.0625f * LOG2E;
constexpr float LAM0 = 0.2f;

constexpr size_t O_YP = 0, O_YS = O_YP + (size_t)MP * DMODEL, O_KP = O_YS + (size_t)MS * DMODEL, O_VP = O_KP + (size_t)MP * 512,
                 O_KS = O_VP + (size_t)MP * 512, O_VS = O_KS + (size_t)MS * 512, O_HRP = O_VS + (size_t)MS * 512, O_HIP = O_HRP + NBATCH * NG * NST,
                 O_HRS = O_HIP + NBATCH * NG * NST, O_HIS = O_HRS + (size_t)NDEC * NG * NST, O_CP = O_HIS + (size_t)NDEC * NG * NST,
                 O_CS = O_CP + (size_t)NBATCH * 2 * FF, O_MK = O_CS + (size_t)NDEC * 2 * FF, O_MV = O_MK + (size_t)MMEM * DMODEL, O_END = O_MV + (size_t)MMEM * DMODEL;
static_assert(O_END == 37984256, "output size");

enum { I_XP = 0, I_XS, I_MEM, I_CK, I_CV, I_PT, I_SRE, I_SIM, I_SCONV, I_CMK, I_CMV, I_LN1, I_WIN, I_ARE, I_AIM, I_BRE, I_BIM, I_CRE, I_CIM, I_D, I_LDT, I_GLU,
       I_QG, I_KG, I_LQ1, I_LK1, I_LQ2, I_LK2, I_SUBLN, I_WOUT, I_LN2, I_MEMG, I_WQ, I_WK, I_WV, I_CAQG, I_CAKG, I_WO, I_LN3, I_WG, I_WVV, I_CONVW, I_CONVB, I_WD, N_IN };
static_assert(N_IN == 44, "inputs");

constexpr size_t MiB = 1u << 20;
constexpr size_t al(size_t x) { return (x + MiB - 1) / MiB * MiB; }
constexpr size_t WS_CTL = 0, CTL_ZERO_BYTES = 1 * MiB;
constexpr size_t WS_WIN = 2 * MiB;
constexpr size_t WS_WKV = WS_WIN + al((size_t)2048 * 1024 * 2);
constexpr size_t WS_GLU = WS_WKV + al((size_t)2048 * 1024 * 2);
constexpr size_t WS_WOUT = WS_GLU + al((size_t)512 * 512 * 2);
constexpr size_t WS_WQ = WS_WOUT + al((size_t)1024 * 1024 * 2);
constexpr size_t WS_WO = WS_WQ + al((size_t)1024 * 1024 * 2);
constexpr size_t WS_WG = WS_WO + al((size_t)1024 * 1024 * 2);
constexpr size_t WS_WV = WS_WG + al((size_t)FF * 1024 * 2);
constexpr size_t WS_WD = WS_WV + al((size_t)FF * 1024 * 2);
constexpr size_t WS_TQ = WS_WD + al((size_t)FF * 1024 * 2);
constexpr size_t WS_PM = WS_TQ + al((size_t)NG * 256 * 384 * 2);
constexpr size_t WS_SSMF = WS_PM + al((size_t)NG * 128 * 256 * 2);
constexpr size_t WS_MN = WS_SSMF + 1 * MiB;
constexpr size_t WS_MKB = WS_MN + al((size_t)MMEM * 1024 * 2);
constexpr size_t WS_MVB = WS_MKB + al((size_t)MMEM * 1024 * 2);
constexpr size_t WS_SS1 = WS_MVB + al((size_t)MMEM * 1024 * 2);
constexpr size_t WS_SS2 = WS_SS1 + al((size_t)MTOT * 16 * 4);
constexpr size_t WS_SSQ = WS_SS2 + al((size_t)MTOT * 16 * 4);
constexpr size_t WS_XN1 = WS_SSQ + 1 * MiB;
constexpr size_t WS_UG = WS_XN1 + al((size_t)MTOT * 1024 * 2);
constexpr size_t WS_QB = WS_UG + al((size_t)MTOT * 512 * 2);
constexpr size_t WS_KB = WS_QB + al((size_t)MTOT * 512 * 2);
constexpr size_t WS_VB = WS_KB + al((size_t)MTOT * 512 * 2);
constexpr size_t WS_O0 = WS_VB + al((size_t)MTOT * 512 * 2);
constexpr size_t WS_O1 = WS_O0 + al((size_t)MTOT * 512 * 2);
constexpr size_t WS_G = WS_O1 + al((size_t)MTOT * 512 * 2);
constexpr size_t WS_MIX = WS_G + al((size_t)MTOT * 512 * 2);
constexpr size_t WS_X1 = WS_MIX + al((size_t)MTOT * 1024 * 2);
constexpr size_t WS_XB1 = WS_X1 + al((size_t)MTOT * 1024 * 4);
constexpr size_t WS_CQ = WS_XB1 + al((size_t)MTOT * 1024 * 2);
constexpr size_t WS_CO = WS_CQ + al((size_t)MTOT * 1024 * 2);
constexpr size_t WS_X2 = WS_CO + al((size_t)MTOT * 1024 * 2);
constexpr size_t WS_XB2 = WS_X2 + al((size_t)MTOT * 1024 * 4);
constexpr size_t WS_HG = WS_XB2 + al((size_t)MTOT * 1024 * 2);
constexpr size_t WS_H = WS_UG;
static_assert(WS_UG + (size_t)MTOT * FF * 2 <= WS_MIX, "h overlay");
constexpr size_t WS_END = WS_HG + al((size_t)MTOT * FF * 2);
constexpr int SF_LBL = 0;
constexpr int SF_LB1 = SF_LBL + NG * 128;
constexpr int SF_BB = SF_LB1 + NG * 128;
constexpr int SF_END = SF_BB + NG * 64 * 16 * 2;
static_assert((size_t)SF_END * 4 <= 1 * MiB, "ssm f32 tables");

constexpr int CW_BAR = 4096;
constexpr int CW_QUEUE2 = 128;
constexpr int CW_QUEUE = 64;

constexpr int RING_BYTES = 131072;
constexpr int MISC_OFF = RING_BYTES + 64;
constexpr int EPI_SCR_OFF = RING_BYTES + 1024;
constexpr int EPI_RS_OFF = EPI_SCR_OFF + 4096;
constexpr int EPI_HALO_OFF = EPI_RS_OFF + 1024;
constexpr int LDS_BYTES = 147456;
static_assert(EPI_HALO_OFF + 6 * 4 * 2 * 32 * 4 <= LDS_BYTES, "LDS map");

__device__ __forceinline__ size_t hidx(size_t r, int c) { return ((size_t)(c >> 6) * MTOT + r) * 64 + (c & 63); }
typedef float f32x2pk __attribute__((ext_vector_type(2))); typedef __bf16 bf16x2pk __attribute__((ext_vector_type(2)));
__device__ __forceinline__ unsigned pk2(float lo, float hi) { const f32x2pk v = {lo, hi}; return __builtin_bit_cast(unsigned, __builtin_convertvector(v, bf16x2pk)); }
__device__ __forceinline__ unsigned f2bf(float f) { return pk2(f, 0.f) & 0xffffu; }
__device__ __forceinline__ float bf2f(unsigned h) { return __builtin_bit_cast(float, h << 16); }
__device__ __forceinline__ float bflo(unsigned w) { return __builtin_bit_cast(float, w << 16); }
__device__ __forceinline__ float bfhi(unsigned w) { return __builtin_bit_cast(float, w & 0xffff0000u); }
#define DPP_F(old, x, ctrl, rmask, bc) __builtin_bit_cast(float, __builtin_amdgcn_update_dpp(__builtin_bit_cast(int, (old)), __builtin_bit_cast(int, (x)), (ctrl), (rmask), 0xf, (bc)))
__device__ __forceinline__ float wave_sum(float v) {
    v += DPP_F(0.f, v, 0x111, 0xf, true); v += DPP_F(0.f, v, 0x112, 0xf, true); v += DPP_F(0.f, v, 0x114, 0xf, true); v += DPP_F(0.f, v, 0x118, 0xf, true);
    v += DPP_F(0.f, v, 0x142, 0xa, false); v += DPP_F(0.f, v, 0x143, 0xc, false);
    return __builtin_bit_cast(float, __builtin_amdgcn_readlane(__builtin_bit_cast(int, v), 63));
}
__device__ __forceinline__ float wave_max(float v) {
    v = fmaxf(v, DPP_F(v, v, 0x111, 0xf, false)); v = fmaxf(v, DPP_F(v, v, 0x112, 0xf, false)); v = fmaxf(v, DPP_F(v, v, 0x114, 0xf, false)); v = fmaxf(v, DPP_F(v, v, 0x118, 0xf, false));
    v = fmaxf(v, DPP_F(v, v, 0x142, 0xa, false)); v = fmaxf(v, DPP_F(v, v, 0x143, 0xc, false));
    return __builtin_bit_cast(float, __builtin_amdgcn_readlane(__builtin_bit_cast(int, v), 63));
}
__device__ __forceinline__ float quad_allsum(float v) { v += DPP_F(0.f, v, 0xB1, 0xf, true); v += DPP_F(0.f, v, 0x4E, 0xf, true); return v; }
__device__ __forceinline__ float oct_allsum(float v) { v = quad_allsum(v); v += DPP_F(0.f, v, 0x141, 0xf, true); return v; }
__device__ __forceinline__ float row_allsum(float v) { v = oct_allsum(v); v += DPP_F(0.f, v, 0x140, 0xf, true); return v; }
#define LDS_WAIT() asm volatile("s_waitcnt lgkmcnt(0)" ::: "memory")
#define VM_WAIT() asm volatile("s_waitcnt vmcnt(0)" ::: "memory")
#define XB_TMO      128
#define XB_XCNT(j)  (256  + 64 * (j))
#define XB_XSUB(j)  (1280 + 64 * (j))
#define XB_XGEN(j)  (2304 + 64 * (j))
#define XB_TOP      3328
#define XB_TOPGEN   3392
#define XCD_BAR_WORDS 3456
#define XB_SPIN_CAP (1u << 18)

__device__ __forceinline__ unsigned xb_ld(unsigned* p)              { return __hip_atomic_load(p, __ATOMIC_RELAXED, __HIP_MEMORY_SCOPE_AGENT); }
__device__ __forceinline__ unsigned xb_add(unsigned* p, unsigned v) { return __hip_atomic_fetch_add(p, v, __ATOMIC_RELAXED, __HIP_MEMORY_SCOPE_AGENT); }
__device__ __forceinline__ unsigned xb_xcc_id() { return (unsigned)__builtin_amdgcn_s_getreg((3 << 11) | 20) & 0xFu; }
#define XB_SPIN(cond, bar) do { unsigned _sp = 0; while (cond) { __builtin_amdgcn_s_sleep(1); \
    if ((++_sp & 255u) == 0u) { if (xb_ld(&(bar)[XB_TMO])) break; if (_sp > XB_SPIN_CAP) { atomicAdd(&(bar)[XB_TMO], 1u); break; } } } } while (0)

struct XcdBarrier {
    unsigned* bar; unsigned x;
    volatile LAS unsigned* st;
};

__device__ __forceinline__ XcdBarrier xcd_barrier_post(unsigned* bar, volatile LAS unsigned* st) {
    XcdBarrier b; b.bar = bar; b.x = xb_xcc_id(); b.st = st;
    if (threadIdx.x == 0) (void)xb_add(&bar[XB_XCNT(b.x)], 1u);
    return b;
}
__device__ __forceinline__ void xcd_barrier_complete(unsigned* bar, unsigned x, unsigned& nloc, unsigned& nx) {
    const unsigned G = gridDim.x * gridDim.y * gridDim.z;
    unsigned sum, cnt, mine, sp = 0u;
    for (;;) {
        sum = 0u; cnt = 0u; mine = 0u;
#pragma unroll
        for (unsigned j = 0; j < 16; ++j) { const unsigned c = xb_ld(&bar[XB_XCNT(j)]); sum += c; cnt += (c > 0u) ? 1u : 0u; mine = (j == x) ? c : mine; }
        if (sum == G) break;
        __builtin_amdgcn_s_sleep(1);
        if ((++sp & 255u) == 0u) { if (xb_ld(&bar[XB_TMO])) break; if (sp > XB_SPIN_CAP) { atomicAdd(&bar[XB_TMO], 1u); break; } }
    }
    nloc = mine > 0u ? mine : 1u; nx = cnt > 0u ? cnt : 1u;
}

__device__ __forceinline__ void xcd_barrier(const XcdBarrier& b) {
    asm volatile("s_waitcnt vmcnt(0)" ::: "memory");
    __syncthreads();
    if (threadIdx.x == 0) {
        unsigned* bar = b.bar;
        __builtin_amdgcn_s_waitcnt(0);
        unsigned nloc = b.st[0], nx = b.st[1];
        if (nloc == 0u) { xcd_barrier_complete(bar, b.x, nloc, nx); b.st[0] = nloc; b.st[1] = nx; }
        const unsigned old = xb_add(&bar[XB_XSUB(b.x)], 1u);
        const unsigned gen = old / nloc;
        if (old + 1u == (gen + 1u) * nloc) {
            __builtin_amdgcn_fence(__ATOMIC_RELEASE, "agent");
            asm volatile("s_waitcnt vmcnt(0)" ::: "memory");
            const unsigned og = xb_add(&bar[XB_TOP], 1u);
            const unsigned tg = og / nx;
            if (og + 1u == (tg + 1u) * nx) xb_add(&bar[XB_TOPGEN], 1u);
            else XB_SPIN(xb_ld(&bar[XB_TOPGEN]) == tg, bar);
            __builtin_amdgcn_fence(__ATOMIC_ACQUIRE, "agent");
            xb_add(&bar[XB_XGEN(b.x)], 1u);
            asm volatile("s_waitcnt vmcnt(0)" ::: "memory");
        } else {
            XB_SPIN(xb_ld(&bar[XB_XGEN(b.x)]) == gen, bar);
            __builtin_amdgcn_fence(__ATOMIC_ACQUIRE, "agent");
            asm volatile("s_waitcnt vmcnt(0)" ::: "memory");
        }
    }
    __syncthreads();
}
__device__ __forceinline__ int colpos(int n0) { const int a = n0 & 255; return (n0 & ~255) + 128 * ((a >> 5) & 1) + 32 * (a >> 6); }
__device__ __forceinline__ void transpose_item(const float* W, int K, int N, bf16* WT, int row_off, LAS float* scr, int item, int lane, const float* kgain = nullptr, int posmode = 0) {
    const int nblk = N / 32, kb = item / nblk, nb = item % nblk, k0 = 64 * kb, n0 = 32 * nb;
    float wv[32];
#pragma unroll
    for (int i = 0; i < 32; ++i) wv[i] = W[(size_t)(k0 + 2 * i + (lane >> 5)) * N + n0 + (lane & 31)];
    if (kgain) {
#pragma unroll
        for (int i = 0; i < 32; ++i) wv[i] *= kgain[k0 + 2 * i + (lane >> 5)]; }
#pragma unroll
    for (int i = 0; i < 32; ++i) scr[(2 * i + (lane >> 5)) * 33 + (lane & 31)] = wv[i];
    LDS_WAIT(); asm volatile("" ::: "memory");
    const int c = lane & 7; const int prow = row_off + (posmode == 0 ? colpos(n0) : 256 * (n0 >> 7) + 32 * ((n0 >> 5) & 3) + (posmode == 2 ? 128 : 0));
#pragma unroll
    for (int j = 0; j < 4; ++j) { const int n = (lane >> 3) + 8 * j; const LAS float* s = scr + (8 * c) * 33 + n;
        u32x4 o; o.x = pk2(s[0 * 33], s[1 * 33]); o.y = pk2(s[2 * 33], s[3 * 33]); o.z = pk2(s[4 * 33], s[5 * 33]); o.w = pk2(s[6 * 33], s[7 * 33]);
        *(GAS u32x4*)(WT + (size_t)(prow + n) * K + k0 + 8 * c) = o; }
    LDS_WAIT(); asm volatile("" ::: "memory");
}
__device__ __forceinline__ void rms_row_to_bf16(const float* xrow, const float* g, bf16* orow, int lane) {
    const GAS f32x4* xr = (const GAS f32x4*)xrow + lane; const GAS f32x4* gr = (const GAS f32x4*)g + lane;
    f32x4 v[4]; float s = 0.f;
#pragma unroll
    for (int j = 0; j < 4; ++j) { v[j] = xr[64 * j]; s += (v[j].x * v[j].x + v[j].y * v[j].y) + (v[j].z * v[j].z + v[j].w * v[j].w); }
    const float rinv = 1.f / sqrtf(wave_sum(s) * (1.f / DMODEL) + EPS);
    GAS unsigned long long* o8 = (GAS unsigned long long*)orow + lane;
#pragma unroll
    for (int j = 0; j < 4; ++j) { const f32x4 gg = gr[64 * j]; const f32x4 y = v[j] * rinv * gg;
        o8[64 * j] = (unsigned long long)pk2(y.x, y.y) | ((unsigned long long)pk2(y.z, y.w) << 32); }
}
__device__ __forceinline__ void ssm_tables(const float* are_, const float* aim_, const float* bre_, const float* bim_, const float* cre_, const float* cim_, const float* dd_, const float* ldt_,
                                           bf16* TQ, bf16* PM, float* SF, int g, int part, LAS float* L, int tid) {
    LAS float* lbp = L;
    LAS float* Bb = L + 17 * 128;
    LAS float* Kt = Bb + 64 * 32;
    LAS float* Cc = Kt + 16 * 256;
    const float dtf = expf(ldt_[g]);
    for (int idx = tid; idx < 17 * 64; idx += 512) { const int j = idx >> 6, p = idx & 63; const float ar = are_[g * 64 + p], ai = aim_[g * 64 + p];
        const float mag = expf(ar * dtf * (float)j); double ang = (double)ai * (double)dtf * (double)j; ang -= 6.283185307179586 * rint(ang * 0.15915494309189535);
        const float af = (float)ang; lbp[idx * 2] = mag * cosf(af); lbp[idx * 2 + 1] = mag * sinf(af); }
    for (int i = tid; i < 1024; i += 512) { Cc[i * 2] = cre_[g * 1024 + i]; Cc[i * 2 + 1] = cim_[g * 1024 + i]; }
    __syncthreads();
    for (int idx = tid; idx < 1024; idx += 512) { const int p = idx >> 4, c = idx & 15; const float ar = are_[g * 64 + p], ai = aim_[g * 64 + p], lr = lbp[(64 + p) * 2], li = lbp[(64 + p) * 2 + 1];
        const float den = ar * ar + ai * ai, nre = lr - 1.0f; const float fre = (nre * ar + li * ai) / den, fim = (li * ar - nre * ai) / den;
        const float br = bre_[(g * 64 + p) * 16 + c], bi = bim_[(g * 64 + p) * 16 + c];
        Bb[idx * 2] = fre * br - fim * bi; Bb[idx * 2 + 1] = fre * bi + fim * br; }
    __syncthreads();
    if (part == 0) {
        if (tid < 128) { const int p = tid & 63, im = tid >> 6; SF[SF_LBL + g * 128 + im * 64 + p] = lbp[(16 * 64 + p) * 2 + im]; SF[SF_LB1 + g * 128 + im * 64 + p] = lbp[(1 * 64 + p) * 2 + im]; }
        for (int i = tid; i < 2048; i += 512) SF[SF_BB + g * 2048 + i] = Bb[i];
    }
    const int j0 = 2 * part;
    { const int e = tid, j = j0 + (e >> 8), c = (e >> 4) & 15, c2 = e & 15; float s = 0.f;
      for (int p = 0; p < 64; ++p) { const float cr = Cc[(c * 64 + p) * 2], ci = Cc[(c * 64 + p) * 2 + 1], lr = lbp[(j * 64 + p) * 2], li = lbp[(j * 64 + p) * 2 + 1];
          const float xr = cr * lr - ci * li, xi = cr * li + ci * lr; s += xr * Bb[(p * 16 + c2) * 2] - xi * Bb[(p * 16 + c2) * 2 + 1]; }
      if (j == 0 && c == c2) s += dd_[g * 16 + c];
      Kt[e] = s; }
    __syncthreads();
    bf16* tq = TQ + (size_t)g * 256 * 384;
    for (int jj = 0; jj < 2; ++jj) { const int j = j0 + jj; const int n = (16 - j) * 256;
        for (int idx = tid; idx < n; idx += 512) { const int t = j + (idx >> 8), c = (idx >> 4) & 15, c2 = idx & 15;
            tq[(size_t)(t * 16 + c) * 384 + (t - j) * 16 + c2] = (bf16)f2bf(Kt[jj * 256 + c * 16 + c2]); } }
    for (int idx = part * 32 * 384 + tid; idx < (part + 1) * 32 * 384; idx += 512) {
        const int row = idx / 384, k = idx - row * 384, t = row >> 4, c = row & 15;
        if (k < 256) { if ((k >> 4) > t) tq[idx] = 0; }
        else { const int q = k - 256, p = q & 63, im = q >> 6; const float cr = Cc[(c * 64 + p) * 2], ci = Cc[(c * 64 + p) * 2 + 1], lr = lbp[((t + 1) * 64 + p) * 2], li = lbp[((t + 1) * 64 + p) * 2 + 1];
            tq[idx] = (bf16)f2bf(im ? -(cr * li + ci * lr) : (cr * lr - ci * li)); }
    }
    bf16* pm = PM + (size_t)g * 128 * 256;
    for (int idx = part * 16 * 256 + tid; idx < (part + 1) * 16 * 256; idx += 512) {
        const int pr = idx >> 8, k = idx & 255, p = pr & 63, im = pr >> 6, s = k >> 4, c2 = k & 15;
        const float lr = lbp[((15 - s) * 64 + p) * 2], li = lbp[((15 - s) * 64 + p) * 2 + 1], br = Bb[(p * 16 + c2) * 2], bi = Bb[(p * 16 + c2) * 2 + 1];
        pm[idx] = (bf16)f2bf(im ? (lr * bi + li * br) : (lr * br - li * bi));
    }
    __syncthreads();
}
#ifndef DBG_KV
#define DBG_KV 1.0f
#endif
#ifndef DBG_MKV
#define DBG_MKV 1.0f
#endif
namespace ep {
using pg8::Unit; using pg8::cvt_pk_bf16;
__device__ __forceinline__ u32x4 pack8(const f32x4 a, const f32x4 b) { u32x4 w; w.x = cvt_pk_bf16(a[0], a[1]); w.y = cvt_pk_bf16(a[2], a[3]); w.z = cvt_pk_bf16(b[0], b[1]); w.w = cvt_pk_bf16(b[2], b[3]); return w; }
__device__ __forceinline__ float sq4(const f32x4 x) { return (x[0] * x[0] + x[1] * x[1]) + (x[2] * x[2] + x[3] * x[3]); }
__device__ __forceinline__ void wave_row_ss(const f32x4 (&acc)[2][2][4][2], float (&ss)[2][4]) {
#pragma unroll
    for (int ai = 0; ai < 2; ++ai)
#pragma unroll
        for (int m = 0; m < 4; ++m) { float s = (sq4(acc[ai][0][m][0]) + sq4(acc[ai][0][m][1])) + (sq4(acc[ai][1][m][0]) + sq4(acc[ai][1][m][1]));
            s += __shfl_xor(s, 16); s += __shfl_xor(s, 32); ss[ai][m] = s; }
}
__device__ __forceinline__ void tile_row_ss(const f32x4 (&acc)[2][2][4][2], LAS float* scr, int wr, int wc, int fr, int fq, float (&ss)[2][4]) {
    wave_row_ss(acc, ss);
    if (fq == 0) {
#pragma unroll
        for (int ai = 0; ai < 2; ++ai)
#pragma unroll
            for (int m = 0; m < 4; ++m) scr[(128 * ai + 64 * wr + 16 * m + fr) * 4 + wc] = ss[ai][m];
    }
    asm volatile("s_waitcnt lgkmcnt(0)" ::: "memory"); __builtin_amdgcn_s_barrier(); asm volatile("" ::: "memory");
#pragma unroll
    for (int ai = 0; ai < 2; ++ai)
#pragma unroll
        for (int m = 0; m < 4; ++m) { const f32x4 t = *(const LAS f32x4*)(scr + (128 * ai + 64 * wr + 16 * m + fr) * 4); ss[ai][m] = (t[0] + t[1]) + (t[2] + t[3]); }
}

struct EpiIn {
    static constexpr bool PERM = true, AFTER_DRAIN = false;
    bf16 *UG, *Qb, *Kb, *Vb; float* out; const float *qg, *kg;
    __device__ __forceinline__ void operator()(const f32x4 (&acc)[2][2][4][2], const Unit& u, int wr, int wc, int fr, int fq) const {
        const int pn = u.pn, row0 = u.pm * 256 + wr * 64 + fr, cw = 64 * wc + 8 * fq;
        if (pn < 2) {
#pragma unroll
            for (int ai = 0; ai < 2; ++ai)
#pragma unroll
                for (int m = 0; m < 4; ++m) { const int r = row0 + 128 * ai + 16 * m;
#pragma unroll
                    for (int bj = 0; bj < 2; ++bj) { const int ch = 256 * pn + cw + 32 * bj;
                        *(u32x4*)(UG + ((size_t)(ch >> 4) * MTOT + r) * 16 + (ch & 15)) = pack8(acc[ai][bj][m][0], acc[ai][bj][m][1]); } }
        } else if (pn < 6) {
            const bool isq = pn < 4; const float* g = isq ? qg : kg; const float sc = isq ? C2 : 1.f;
            f32x4 gv[2][2];
#pragma unroll
            for (int bj = 0; bj < 2; ++bj)
#pragma unroll
                for (int n = 0; n < 2; ++n) gv[bj][n] = *(const f32x4*)(g + 32 * bj + 8 * fq + 4 * n) * sc;
            float ss[2][4]; wave_row_ss(acc, ss);
            const int c0 = (isq ? (pn - 2) : (pn - 4)) * 256 + cw;
            bf16* B = isq ? Qb : Kb;
            float* kout = (u.pm < MP / 256) ? out + O_KP : out + O_KS - (size_t)MP * 512;
#pragma unroll
            for (int ai = 0; ai < 2; ++ai)
#pragma unroll
                for (int m = 0; m < 4; ++m) { const int r = row0 + 128 * ai + 16 * m; const float rinv = 1.f / sqrtf(ss[ai][m] * (1.f / 64.f) + EPS);
#pragma unroll
                    for (int bj = 0; bj < 2; ++bj) { const f32x4 v0 = acc[ai][bj][m][0] * rinv * gv[bj][0], v1 = acc[ai][bj][m][1] * rinv * gv[bj][1];
                        *(u32x4*)(B + (size_t)r * 512 + c0 + 32 * bj) = pack8(v0, v1);
                        if (!isq) { float* o = kout + (size_t)r * 512 + c0 + 32 * bj; *(f32x4*)o = v0 * DBG_KV; *(f32x4*)(o + 4) = v1 * DBG_KV; } } }
        } else {
            const int c0 = (pn - 6) * 256 + cw;
            float* vout = (u.pm < MP / 256) ? out + O_VP : out + O_VS - (size_t)MP * 512;
#pragma unroll
            for (int ai = 0; ai < 2; ++ai)
#pragma unroll
                for (int m = 0; m < 4; ++m) { const int r = row0 + 128 * ai + 16 * m;
#pragma unroll
                    for (int bj = 0; bj < 2; ++bj) { const f32x4 v0 = acc[ai][bj][m][0], v1 = acc[ai][bj][m][1];
                        *(u32x4*)(Vb + (size_t)r * 512 + c0 + 32 * bj) = pack8(v0, v1);
                        float* o = vout + (size_t)r * 512 + c0 + 32 * bj; *(f32x4*)o = v0 * DBG_KV; *(f32x4*)(o + 4) = v1 * DBG_KV; } }
        }
    }
};
struct EpiMemKV {
    static constexpr bool PERM = true, AFTER_DRAIN = false;
    float* out; bf16 *MKb, *MVb; const float* kg; LAS float* scr;
    __device__ __forceinline__ void operator()(const f32x4 (&acc)[2][2][4][2], const Unit& u, int wr, int wc, int fr, int fq) const {
        const int pn = u.pn, row0 = u.pm * 256 + wr * 64 + fr, cw = 64 * wc + 8 * fq;
        const bool isk = pn < 4; const int c0 = (pn & 3) * 256 + cw;
        float ss[2][4];
        f32x4 gv[2][2];
        if (isk) { tile_row_ss(acc, scr, wr, wc, fr, fq, ss);
#pragma unroll
            for (int bj = 0; bj < 2; ++bj)
#pragma unroll
                for (int n = 0; n < 2; ++n) gv[bj][n] = *(const f32x4*)(kg + cw + 32 * bj + 4 * n); }
        float* o32 = out + (isk ? O_MK : O_MV); bf16* ob = isk ? MKb : MVb;
#pragma unroll
        for (int ai = 0; ai < 2; ++ai)
#pragma unroll
            for (int m = 0; m < 4; ++m) { const int r = row0 + 128 * ai + 16 * m; const float rinv = isk ? 1.f / sqrtf(ss[ai][m] * (1.f / 256.f) + EPS) : 1.f;
#pragma unroll
                for (int bj = 0; bj < 2; ++bj) { f32x4 v0 = acc[ai][bj][m][0], v1 = acc[ai][bj][m][1];
                    if (isk) { v0 = v0 * rinv * gv[bj][0]; v1 = v1 * rinv * gv[bj][1]; }
                    *(u32x4*)(ob + (size_t)r * 1024 + c0 + 32 * bj) = pack8(v0, v1);
                    float* o = o32 + (size_t)r * 1024 + c0 + 32 * bj; *(f32x4*)o = v0 * DBG_MKV; *(f32x4*)(o + 4) = v1 * DBG_MKV; } }
    }
};
}
namespace ep {
__device__ __forceinline__ float row_rs(const float* SS, int r) {
    const f32x4* p = (const f32x4*)(SS + (size_t)r * 16); const f32x4 a = p[0], b = p[1], c = p[2], d = p[3];
    const float s = ((a[0] + a[1]) + (a[2] + a[3])) + ((b[0] + b[1]) + (b[2] + b[3])) + ((c[0] + c[1]) + (c[2] + c[3])) + ((d[0] + d[1]) + (d[2] + d[3]));
    return 1.f / sqrtf(s * (1.f / DMODEL) + EPS);
}
__device__ __forceinline__ void tile_rs(const float* SS, int pm, LAS float* rsl) {
    const int tid = threadIdx.x;
    if (tid < 256) rsl[tid] = row_rs(SS, pm * 256 + tid);
    asm volatile("s_waitcnt lgkmcnt(0)" ::: "memory"); __builtin_amdgcn_s_barrier(); asm volatile("" ::: "memory");
}
__device__ __forceinline__ float sigm(float x) { return 1.f / (1.f + __builtin_amdgcn_exp2f(-LOG2E * x)); }
__device__ __forceinline__ f32x4 ld4bf(const bf16* p) { const u32x2 w = *(const u32x2*)p; return (f32x4){bflo(w.x), bfhi(w.x), bflo(w.y), bfhi(w.y)}; }
#define EP_ROWS(...) _Pragma("unroll") for (int ai = 0; ai < 2; ++ai) _Pragma("unroll") for (int m = 0; m < 4; ++m) { const int r = row0 + 128 * ai + 16 * m; __VA_ARGS__ }
struct EpiGlu {
    static constexpr bool PERM = true, AFTER_DRAIN = false;
    const bf16* Gb; bf16* MIX;
    __device__ __forceinline__ void operator()(const f32x4 (&acc)[2][2][4][2], const Unit& u, int wr, int wc, int fr, int fq) const {
        const int row0 = u.pm * 256 + wr * 64 + fr, c0 = u.pn * 256 + 64 * wc + 8 * fq;
        EP_ROWS(
_Pragma("unroll")
            for (int bj = 0; bj < 2; ++bj) { const int c = c0 + 32 * bj; const f32x4 g0 = ld4bf(Gb + (size_t)r * 512 + c), g1 = ld4bf(Gb + (size_t)r * 512 + c + 4);
                f32x4 v0, v1;
_Pragma("unroll")
                for (int j = 0; j < 4; ++j) { v0[j] = g0[j] * sigm(acc[ai][bj][m][0][j]); v1[j] = g1[j] * sigm(acc[ai][bj][m][1][j]); }
                *(u32x4*)(MIX + (size_t)r * 1024 + c) = pack8(v0, v1); } )
    }
};
template <bool RES_BF16> struct EpiRes {
    static constexpr bool PERM = true, AFTER_DRAIN = false;
    const void* resP;
    bf16* XB; float* SS;
    __device__ __forceinline__ void operator()(const f32x4 (&acc)[2][2][4][2], const Unit& u, int wr, int wc, int fr, int fq) const {
        const int row0 = u.pm * 256 + wr * 64 + fr, c0 = u.pn * 256 + 64 * wc + 8 * fq;
_Pragma("unroll")
        for (int ai = 0; ai < 2; ++ai) {
            u32x4 rb[4][2]; f32x4 rf[4][2][2];
_Pragma("unroll")
            for (int m = 0; m < 4; ++m)
_Pragma("unroll")
                for (int bj = 0; bj < 2; ++bj) { const size_t off = (size_t)(row0 + 128 * ai + 16 * m) * DMODEL + c0 + 32 * bj;
                    if (RES_BF16) rb[m][bj] = *(const u32x4*)((const bf16*)resP + off);
                    else { rf[m][bj][0] = *(const f32x4*)((const float*)resP + off); rf[m][bj][1] = *(const f32x4*)((const float*)resP + off + 4); } }
            asm volatile("" ::: "memory");
_Pragma("unroll")
            for (int m = 0; m < 4; ++m) { const int r = row0 + 128 * ai + 16 * m; float s = 0.f;
_Pragma("unroll")
                for (int bj = 0; bj < 2; ++bj) { const size_t off = (size_t)r * DMODEL + c0 + 32 * bj; f32x4 x0, x1;
                    if (RES_BF16) { const u32x4 w = rb[m][bj]; x0 = (f32x4){bflo(w.x), bfhi(w.x), bflo(w.y), bfhi(w.y)}; x1 = (f32x4){bflo(w.z), bfhi(w.z), bflo(w.w), bfhi(w.w)}; }
                    else { x0 = rf[m][bj][0]; x1 = rf[m][bj][1]; }
                    x0 += acc[ai][bj][m][0]; x1 += acc[ai][bj][m][1]; s += sq4(x0) + sq4(x1);
                    *(u32x4*)(XB + off) = pack8(x0, x1); }
                s += __shfl_xor(s, 16); s += __shfl_xor(s, 32);
                if (fq == 0) SS[(size_t)r * 16 + 4 * u.pn + wc] = s; }
        }
    }
};
struct EpiCq {
    static constexpr bool PERM = true, AFTER_DRAIN = false;
    const float* SS; bf16* CQ; const float* gq; LAS float* scr; LAS float* rsl;
    __device__ __forceinline__ void operator()(const f32x4 (&acc)[2][2][4][2], const Unit& u, int wr, int wc, int fr, int fq) const {
        const int row0 = u.pm * 256 + wr * 64 + fr, cw = 64 * wc + 8 * fq, c0 = u.pn * 256 + cw;
        tile_rs(SS, u.pm, rsl);
        float ss[2][4]; tile_row_ss(acc, scr, wr, wc, fr, fq, ss);
        f32x4 gv[2][2];
_Pragma("unroll")
        for (int bj = 0; bj < 2; ++bj)
_Pragma("unroll")
            for (int n = 0; n < 2; ++n) gv[bj][n] = *(const f32x4*)(gq + cw + 32 * bj + 4 * n) * CA2;
        EP_ROWS( const float rs = rsl[r & 255]; const float sc = rs / sqrtf(rs * rs * ss[ai][m] * (1.f / 256.f) + EPS);
_Pragma("unroll")
            for (int bj = 0; bj < 2; ++bj) *(u32x4*)(CQ + (size_t)r * 1024 + c0 + 32 * bj) = pack8(acc[ai][bj][m][0] * sc * gv[bj][0], acc[ai][bj][m][1] * sc * gv[bj][1]); )
    }
};
#ifndef FFN_ROR_FLIP
#define FFN_ROR_FLIP 0
#endif
template <int N> __device__ __forceinline__ float row_from_below(float v) {
    return __builtin_bit_cast(float, __builtin_amdgcn_update_dpp(0, __builtin_bit_cast(int, v), 0x120 + (FFN_ROR_FLIP ? 16 - N : N), 0xf, 0xf, false));
}
struct RunOrder {
    int pn, pm0, len;
    __device__ __forceinline__ void init(int run) { pn = run / 11; const int k = run - pn * 11; len = k < 9 ? 6 : 5; pm0 = k < 9 ? 6 * k : 54 + 5 * (k - 9); }
    __device__ __forceinline__ bool next(int i, Unit& u) const { if (i >= len) return false; u.pm = pm0 + i; u.pn = pn; return true; }
    __device__ __forceinline__ void a_ready(const Unit&) const {}
    __device__ __forceinline__ void done(const Unit&) const {}
};
constexpr int FFN_RUNS = 22 * 11;
__device__ __forceinline__ int halo_idx(int slot, int wc, int row, int ci) { return ((slot * 4 + wc) * 2 + row) * 32 + ci; }
__device__ __forceinline__ void ffn_carry_init(const bf16* XB2, const bf16* WGV, const float* SS, int pm0, int pn, LAS float* hal, int tid) {
    const int ch = tid >> 2, kq = tid & 3, slot = 4 + (pm0 & 1);
    float d0 = 0.f, d1 = 0.f;
    if ((pm0 & 15) != 0) {
        const bf16* wrow = WGV + (size_t)(256 * pn + ch) * DMODEL + 256 * kq; const bf16* x0 = XB2 + (size_t)(256 * pm0 - 2) * DMODEL + 256 * kq; const bf16* x1 = x0 + DMODEL;
#pragma unroll 4
        for (int i = 0; i < 32; ++i) { const u32x4 w = *(const u32x4*)(wrow + 8 * i), a = *(const u32x4*)(x0 + 8 * i), b = *(const u32x4*)(x1 + 8 * i);
#pragma unroll
            for (int q = 0; q < 4; ++q) { d0 += bflo(w[q]) * bflo(a[q]) + bfhi(w[q]) * bfhi(a[q]); d1 += bflo(w[q]) * bflo(b[q]) + bfhi(w[q]) * bfhi(b[q]); } }
        d0 = quad_allsum(d0); d1 = quad_allsum(d1);
        d0 *= row_rs(SS, 256 * pm0 - 2); d1 *= row_rs(SS, 256 * pm0 - 1);
    }
    if (kq == 0) { hal[halo_idx(slot, ch >> 5, 0, ch & 31)] = d0; hal[halo_idx(slot, ch >> 5, 1, ch & 31)] = d1; }
    __syncthreads();
}
struct EpiFfn {
    static constexpr bool PERM = true, AFTER_DRAIN = false;
    const float* SS; bf16* H; float* out; const float* cw_; const float* cb_; LAS float* rsl; LAS float* hal;
    __device__ __forceinline__ void operator()(const f32x4 (&acc)[2][2][4][2], const Unit& u, int wr, int wc, int fr, int fq) const {
        const int row0 = u.pm * 256 + wr * 64 + fr, ci0 = 8 * fq, ch0 = u.pn * 128 + 32 * wc + ci0;
        tile_rs(SS, u.pm, rsl);
        f32x4 gs[2][4][2];
_Pragma("unroll")
        for (int ai = 0; ai < 2; ++ai)
_Pragma("unroll")
            for (int m = 0; m < 4; ++m) { const float rs = rsl[128 * ai + 64 * wr + 16 * m + fr]; gs[ai][m][0] = acc[ai][0][m][0] * rs; gs[ai][m][1] = acc[ai][0][m][1] * rs; }
        if (fr >= 14) {
            const bool seq_end = (u.pm & 15) == 15;
_Pragma("unroll")
            for (int ai = 0; ai < 2; ++ai) { const int q = 2 * ai + wr + 1; const int slot = q < 4 ? q : 4 + ((u.pm + 1) & 1); const bool zero = (q == 4) && seq_end;
_Pragma("unroll")
                for (int n = 0; n < 2; ++n) *(LAS f32x4*)(hal + halo_idx(slot, wc, fr - 14, ci0 + 4 * n)) = zero ? (f32x4){0.f, 0.f, 0.f, 0.f} : gs[ai][3][n];
                if (seq_end && ai == 1 && wr == 1) {
                    float* co = out + O_CP + (size_t)((u.pm >> 4) * 2 + (fr - 14)) * FF + ch0; *(f32x4*)co = gs[1][3][0]; *(f32x4*)(co + 4) = gs[1][3][1]; } }
        }
        asm volatile("s_waitcnt lgkmcnt(0)" ::: "memory"); __builtin_amdgcn_s_barrier(); asm volatile("" ::: "memory");
        f32x4 w0[2], w1[2], w2[2], bb[2];
_Pragma("unroll")
        for (int n = 0; n < 2; ++n) { w0[n] = *(const f32x4*)(cw_ + ch0 + 4 * n); w1[n] = *(const f32x4*)(cw_ + FF + ch0 + 4 * n); w2[n] = *(const f32x4*)(cw_ + 2 * FF + ch0 + 4 * n); bb[n] = *(const f32x4*)(cb_ + ch0 + 4 * n); }
_Pragma("unroll")
        for (int ai = 0; ai < 2; ++ai)
_Pragma("unroll")
            for (int m = 0; m < 4; ++m) { const int r = row0 + 128 * ai + 16 * m; const float rs = rsl[128 * ai + 64 * wr + 16 * m + fr]; f32x4 o[2];
_Pragma("unroll")
                for (int n = 0; n < 2; ++n) { f32x4 p1, p2, q1, q2;
                    if (m > 0) {
_Pragma("unroll")
                        for (int j = 0; j < 4; ++j) { q1[j] = row_from_below<1>(gs[ai][m - 1][n][j]); q2[j] = row_from_below<2>(gs[ai][m - 1][n][j]); } }
                    else { const int slot = (2 * ai + wr) ? (2 * ai + wr) : 4 + (u.pm & 1);
                        q1 = *(const LAS f32x4*)(hal + halo_idx(slot, wc, 1, ci0 + 4 * n)); q2 = *(const LAS f32x4*)(hal + halo_idx(slot, wc, fr == 0 ? 0 : 1, ci0 + 4 * n)); }
_Pragma("unroll")
                    for (int j = 0; j < 4; ++j) { p1[j] = row_from_below<1>(gs[ai][m][n][j]); p2[j] = row_from_below<2>(gs[ai][m][n][j]); }
                    const f32x4 h1 = fr >= 1 ? p1 : q1, h0 = fr >= 2 ? p2 : q2;
                    const f32x4 cv = bb[n] + w0[n] * h0 + w1[n] * h1 + w2[n] * gs[ai][m][n];
_Pragma("unroll")
                    for (int j = 0; j < 4; ++j) o[n][j] = cv[j] * sigm(cv[j]) * (acc[ai][1][m][n][j] * rs); }
                *(u32x4*)(H + hidx(r, ch0)) = pack8(o[0], o[1]); }
    }
};
struct EpiOut {
    static constexpr bool PERM = true, AFTER_DRAIN = false;
    const bf16* X2; float* out;
    __device__ __forceinline__ void operator()(const f32x4 (&acc)[2][2][4][2], const Unit& u, int wr, int wc, int fr, int fq) const {
        const int row0 = u.pm * 256 + wr * 64 + fr, c0 = u.pn * 256 + 64 * wc + 8 * fq;
        float* y = (u.pm < MP / 256) ? out + O_YP : out + O_YS - (size_t)MP * DMODEL;
_Pragma("unroll")
        for (int ai = 0; ai < 2; ++ai) { u32x4 rb[4][2];
_Pragma("unroll")
            for (int m = 0; m < 4; ++m)
_Pragma("unroll")
                for (int bj = 0; bj < 2; ++bj) rb[m][bj] = *(const u32x4*)(X2 + (size_t)(row0 + 128 * ai + 16 * m) * DMODEL + c0 + 32 * bj);
            asm volatile("" ::: "memory");
_Pragma("unroll")
            for (int m = 0; m < 4; ++m)
_Pragma("unroll")
                for (int bj = 0; bj < 2; ++bj) { const size_t off = (size_t)(row0 + 128 * ai + 16 * m) * DMODEL + c0 + 32 * bj; const u32x4 w = rb[m][bj];
                    const f32x4 x0 = (f32x4){bflo(w.x), bfhi(w.x), bflo(w.y), bfhi(w.y)}, x1 = (f32x4){bflo(w.z), bfhi(w.z), bflo(w.w), bfhi(w.w)};
                    *(f32x4*)(y + off) = x0 + acc[ai][bj][m][0]; *(f32x4*)(y + off + 4) = x1 + acc[ai][bj][m][1]; } }
    }
};
}
__device__ __forceinline__ float gelu_tanh(float x) {
    const float z = 0.7978845608028654f * (x + 0.044715f * x * x * x);
    return x / (1.f + __builtin_amdgcn_exp2f(-2.f * LOG2E * z));
}
constexpr int SSM_E_PITCH = 132, SSM_S_PITCH = 136;
constexpr int SSM_E_OFF = 0, SSM_S_OFF = 64 * SSM_E_PITCH * 4, SSM_U_OFF = SSM_S_OFF + 64 * SSM_S_PITCH * 2, SSM_U_PITCH = 528;
__device__ __forceinline__ void ssm_prompt_item(const bf16* UG, const bf16* TQ, const bf16* PM, const float* SF, bf16* Gb, float* out, int b, int g, LAS unsigned char* lds, int tid) {
    const int lane = tid & 63, w = __builtin_amdgcn_readfirstlane(tid >> 6), r32 = lane & 31, hi = lane >> 5;
    LAS float* El = (LAS float*)(lds + SSM_E_OFF); LAS bf16* Sl = (LAS bf16*)(lds + SSM_S_OFF); LAS unsigned char* Ul = lds + SSM_U_OFF;
    const bf16* ug = UG + ((size_t)g * MTOT + (size_t)b * SEQ) * 16;
    const bf16* pm = PM + (size_t)g * 128 * 256; const bf16* tq = TQ + (size_t)g * 256 * 384;
    float Sre = 0.f, Sim = 0.f, lr = 0.f, li = 0.f;
    if (w == 0) { lr = SF[SF_LBL + g * 128 + lane]; li = SF[SF_LBL + g * 128 + 64 + lane]; }
    u32x4 ureg[4];
#pragma unroll
    for (int it = 0; it < 4; ++it) ureg[it] = *(const u32x4*)(ug + (size_t)(tid + 512 * it) * 8);
    const int mblk = w & 3, nblk = w >> 2;
    const bf16* apA = pm + (size_t)(32 * mblk + r32) * 256 + 8 * hi; const bf16* apC = tq + (size_t)(32 * w + r32) * 384 + 8 * hi;
    bf16x8 afA[16];
#pragma unroll
    for (int ks = 0; ks < 16; ++ks) afA[ks] = *(const bf16x8*)(apA + 16 * ks);
    bf16x8 afC[24];
#pragma unroll
    for (int ks = 0; ks < 16; ++ks) afC[ks] = *(const bf16x8*)(apC + 16 * ks);
    for (int sc = 0; sc < 4; ++sc) {
        asm volatile("s_waitcnt vmcnt(0)" ::: "memory");
        __syncthreads();
#pragma unroll
        for (int it = 0; it < 4; ++it) { const int idx = tid + 512 * it; *(LAS u32x4*)(Ul + (idx >> 5) * SSM_U_PITCH + (idx & 31) * 16) = ureg[it]; }
        __syncthreads();
        { f32x16 acc = {};
          const LAS unsigned char* bp = Ul + (32 * nblk + r32) * SSM_U_PITCH + 16 * hi;
#pragma unroll
          for (int ks = 0; ks < 16; ++ks) acc = __builtin_amdgcn_mfma_f32_32x32x16_bf16(afA[ks], *(const LAS bf16x8*)(bp + 32 * ks), acc, 0, 0, 0);
#pragma unroll
          for (int r = 0; r < 16; ++r) El[(32 * nblk + r32) * SSM_E_PITCH + 32 * mblk + (r & 3) + 8 * (r >> 2) + 4 * hi] = acc[r]; }
#pragma unroll
        for (int ks = 16; ks < 24; ++ks) afC[ks] = *(const bf16x8*)(apC + 16 * ks);
        __syncthreads();
        if (w == 0) {
#pragma unroll 1
            for (int c0 = 0; c0 < 64; c0 += 8) { float er[8], ei[8];
#pragma unroll
                for (int j = 0; j < 8; ++j) { er[j] = El[(c0 + j) * SSM_E_PITCH + lane]; ei[j] = El[(c0 + j) * SSM_E_PITCH + 64 + lane]; }
#pragma unroll
                for (int j = 0; j < 8; ++j) { Sl[(c0 + j) * SSM_S_PITCH + lane] = (bf16)f2bf(Sre); Sl[(c0 + j) * SSM_S_PITCH + 64 + lane] = (bf16)f2bf(Sim);
                    const float nr = lr * Sre - li * Sim + er[j], ni = lr * Sim + li * Sre + ei[j]; Sre = nr; Sim = ni; } }
        }
        __syncthreads();
        { f32x16 acc0 = {}, acc1 = {};
          const LAS unsigned char* bp0 = Ul + r32 * SSM_U_PITCH + 16 * hi; const LAS unsigned char* bp1 = bp0 + 32 * SSM_U_PITCH;
          asm volatile("s_waitcnt vmcnt(0)" ::: "memory");
#pragma unroll
          for (int ks = 0; ks < 16; ++ks) { acc0 = __builtin_amdgcn_mfma_f32_32x32x16_bf16(afC[ks], *(const LAS bf16x8*)(bp0 + 32 * ks), acc0, 0, 0, 0);
              acc1 = __builtin_amdgcn_mfma_f32_32x32x16_bf16(afC[ks], *(const LAS bf16x8*)(bp1 + 32 * ks), acc1, 0, 0, 0); }
#pragma unroll
          for (int ks = 0; ks < 8; ++ks) {
              const bf16x8 b0 = *(const LAS bf16x8*)(Sl + r32 * SSM_S_PITCH + 16 * ks + 8 * hi), b1 = *(const LAS bf16x8*)(Sl + (32 + r32) * SSM_S_PITCH + 16 * ks + 8 * hi);
              acc0 = __builtin_amdgcn_mfma_f32_32x32x16_bf16(afC[16 + ks], b0, acc0, 0, 0, 0); acc1 = __builtin_amdgcn_mfma_f32_32x32x16_bf16(afC[16 + ks], b1, acc1, 0, 0, 0); }
          if (sc < 3) {
#pragma unroll
              for (int it = 0; it < 4; ++it) ureg[it] = *(const u32x4*)(ug + (size_t)(sc + 1) * 64 * 256 + (size_t)(tid + 512 * it) * 8); }
          const size_t tok0 = (size_t)b * SEQ + (size_t)sc * 1024;
#pragma unroll
          for (int nb = 0; nb < 2; ++nb)
#pragma unroll
              for (int q = 0; q < 4; ++q) { const f32x16& A = nb ? acc1 : acc0; const int t = 2 * w + (q >> 1), c0 = 8 * (q & 1) + 4 * hi; const size_t tok = tok0 + (size_t)(32 * nb + r32) * 16 + t;
                  u32x2 o; o.x = pk2(gelu_tanh(A[4 * q]), gelu_tanh(A[4 * q + 1])); o.y = pk2(gelu_tanh(A[4 * q + 2]), gelu_tanh(A[4 * q + 3]));
                  *(u32x2*)(Gb + tok * 512 + 16 * g + c0) = o; }
 }
    }
    if (w == 0) { out[O_HRP + (b * NG + g) * 64 + lane] = Sre * DBG_SSM; out[O_HIP + (b * NG + g) * 64 + lane] = Sim * DBG_SSM; }
    __syncthreads();
}
__device__ __forceinline__ void ssm_sample_item(const bf16* UG, const float* SF, const float* cre, const float* cim, const float* dd, const float* sre, const float* sim,
                                                bf16* Gb, float* out, int s, int g, LAS float* hs, const LAS float* Cl, int lane) {
    float Sre = sre[(s * NG + g) * 64 + lane], Sim = sim[(s * NG + g) * 64 + lane];
    const float lr = SF[SF_LB1 + g * 128 + lane], li = SF[SF_LB1 + g * 128 + 64 + lane];
    f32x4 bb[8];
#pragma unroll
    for (int i = 0; i < 8; ++i) bb[i] = *(const f32x4*)(SF + SF_BB + g * 2048 + lane * 32 + 4 * i);
    const bf16* up = UG + ((size_t)g * MTOT + MP + 4 * s) * 16;
    u32x4 uw[8];
#pragma unroll
    for (int i = 0; i < 8; ++i) uw[i] = *(const u32x4*)(up + 8 * i);
    const float uval = bf2f(up[lane]), dval = dd[g * 16 + (lane & 15)];
#pragma unroll
    for (int t = 0; t < 4; ++t) { float br = 0.f, bi = 0.f;
#pragma unroll
        for (int c = 0; c < 16; ++c) { const unsigned wd = uw[2 * t + (c >> 3)][(c & 7) >> 1]; const float u = (c & 1) ? bfhi(wd) : bflo(wd);
            br += bb[c >> 1][2 * (c & 1)] * u; bi += bb[c >> 1][2 * (c & 1) + 1] * u; }
        const float nr = lr * Sre - li * Sim + br, ni = lr * Sim + li * Sre + bi; Sre = nr; Sim = ni;
        hs[t * 128 + lane] = Sre; hs[t * 128 + 64 + lane] = Sim; }
    out[O_HRS + (size_t)(s * NG + g) * 64 + lane] = Sre * DBG_SSM; out[O_HIS + (size_t)(s * NG + g) * 64 + lane] = Sim * DBG_SSM;
    LDS_WAIT(); asm volatile("" ::: "memory");
    const int t = lane >> 4, c = lane & 15; float y = 0.f;
#pragma unroll
    for (int p4 = 0; p4 < 16; ++p4) { const f32x4 a = *(const LAS f32x4*)(Cl + c * 68 + 4 * p4), bq = *(const LAS f32x4*)(Cl + 16 * 68 + c * 68 + 4 * p4);
        const f32x4 hr = *(const LAS f32x4*)(hs + t * 128 + 4 * p4), hq = *(const LAS f32x4*)(hs + t * 128 + 64 + 4 * p4);
        y += (a[0] * hr[0] - bq[0] * hq[0]) + (a[1] * hr[1] - bq[1] * hq[1]) + (a[2] * hr[2] - bq[2] * hq[2]) + (a[3] * hr[3] - bq[3] * hq[3]); }
    y += dval * uval;
    Gb[(size_t)(MP + 4 * s + t) * 512 + 16 * g + c] = (bf16)f2bf(gelu_tanh(y));
    LDS_WAIT(); asm volatile("" ::: "memory");
}
namespace attn_body {
using bf16=__hip_bfloat16;
using s16x4=__attribute__((ext_vector_type(4)))short;
constexpr int SEQ=4096,D=64,DM=512;
constexpr int NW=8,QBLK=32,QB=QBLK*NW,KVBLK=64,NQB=SEQ/QB;
constexpr int ATTN_PITCH=DM, ATTN_UNIT_ROWS=QB;
__device__ __forceinline__ int crow(int r,int hi){return (r&3)+8*(r>>2)+4*hi;}
#define SBAR() __builtin_amdgcn_sched_barrier(0)
__device__ __forceinline__ void cmask(f32x16&p0,f32x16&p1,int jb,int qrel,int hi){
  const float NEG=-INFINITY; int kb=64*jb+4*hi;
  #pragma unroll
  for(int r=0;r<16;++r){int kv=kb+(r&3)+8*(r>>2); if(kv>qrel)p0[r]=NEG; if(kv+32>qrel)p1[r]=NEG;}
}

constexpr int NSLOT=3, SLOTB=8192;
constexpr int LDS_K=0, LDS_V=NSLOT*SLOTB, LDS_WS=2*NSLOT*SLOTB, LDS_OST=LDS_WS+NW*64*4, LDS_BYTES=LDS_OST+NW*4096;
constexpr float C2=0.125f*1.4426950408889634f;
__device__ __forceinline__ void glds16(const void*gsrc,unsigned lds_dst){unsigned keep;
  asm volatile("s_mov_b32 %0, m0\n\ts_mov_b32 m0, %2\n\ts_nop 0\n\tglobal_load_lds_dwordx4 %1, off\n\ts_mov_b32 m0, %0":"=&s"(keep):"v"(gsrc),"s"(lds_dst):"memory");}
__device__ __forceinline__ float max3f(float a,float b,float c){float r;asm("v_max3_f32 %0, %1, %2, %3":"=v"(r):"v"(a),"v"(b),"v"(c));return r;}
__device__ __forceinline__ float max2f(float a,float b){float r;asm("v_max_f32_e32 %0, %1, %2":"=v"(r):"v"(a),"v"(b));return r;}
__device__ __forceinline__ float fadd_s(float a,float b){float r;asm("v_add_f32_e32 %0, %1, %2":"=v"(r):"v"(a),"v"(b));return r;}
__device__ __forceinline__ float fsub_s(float a,float b){float r;asm("v_sub_f32_e32 %0, %1, %2":"=v"(r):"v"(a),"v"(b));return r;}
typedef float f32x2_t __attribute__((ext_vector_type(2))); typedef __bf16 bf16x2_t __attribute__((ext_vector_type(2)));
__device__ __forceinline__ unsigned cvtpk_s(float lo,float hi){f32x2_t v={lo,hi};bf16x2_t b=__builtin_convertvector(v,bf16x2_t);return __builtin_bit_cast(unsigned,b);}
#define WAIT_BAR(N) asm volatile("s_waitcnt vmcnt(" #N ") lgkmcnt(0)\n\ts_barrier":::"memory")

__device__ __forceinline__ void qkt(f32x16&p0,f32x16&p1,const char*Kslot,const bf16x8*qr,const f32x16&negm,int r32,int hi){
  const char*kb=Kslot+hi*1024+r32*16;
  #pragma unroll
  for(int d0=0;d0<4;++d0){
    const bf16x8 b0=*reinterpret_cast<const bf16x8*>(kb+d0*2048);
    const bf16x8 b1=*reinterpret_cast<const bf16x8*>(kb+d0*2048+512);
    if(d0==0){p0=__builtin_amdgcn_mfma_f32_32x32x16_bf16(b0,qr[0],negm,0,0,0);p1=__builtin_amdgcn_mfma_f32_32x32x16_bf16(b1,qr[0],negm,0,0,0);}
    else{p0=__builtin_amdgcn_mfma_f32_32x32x16_bf16(b0,qr[d0],p0,0,0,0);p1=__builtin_amdgcn_mfma_f32_32x32x16_bf16(b1,qr[d0],p1,0,0,0);}}
}
typedef __attribute__((address_space(3))) const char* lds_cptr;
typedef short v4i16_t __attribute__((ext_vector_type(4)));
__device__ __forceinline__ void kload8(bf16x8*kf,lds_cptr kp){
  kf[0]=*(const __attribute__((address_space(3))) bf16x8*)(kp);      kf[1]=*(const __attribute__((address_space(3))) bf16x8*)(kp+512);
  kf[2]=*(const __attribute__((address_space(3))) bf16x8*)(kp+2048); kf[3]=*(const __attribute__((address_space(3))) bf16x8*)(kp+2560);
  kf[4]=*(const __attribute__((address_space(3))) bf16x8*)(kp+4096); kf[5]=*(const __attribute__((address_space(3))) bf16x8*)(kp+4608);
  kf[6]=*(const __attribute__((address_space(3))) bf16x8*)(kp+6144); kf[7]=*(const __attribute__((address_space(3))) bf16x8*)(kp+6656);
}
__device__ __forceinline__ void kload2(bf16x8*kf,lds_cptr kp,int j){ kf[2*j]=*(const __attribute__((address_space(3))) bf16x8*)(kp+j*2048); kf[2*j+1]=*(const __attribute__((address_space(3))) bf16x8*)(kp+j*2048+512); }
__device__ __forceinline__ s16x4 vtr(lds_cptr p){ return __builtin_bit_cast(s16x4,__builtin_amdgcn_ds_read_tr16_b64_v4i16((__attribute__((address_space(3))) v4i16_t*)p)); }
__device__ __forceinline__ float rowmax(const f32x16&p0,const f32x16&p1){
  float a=max3f(p0[0],p0[1],p1[0]),b=max3f(p0[2],p0[3],p1[1]);a=max3f(a,p1[2],p1[3]);
  #pragma unroll
  for(int r=4;r<16;r+=4){a=max3f(a,p0[r],p0[r+1]);b=max3f(b,p0[r+2],p0[r+3]);a=max3f(a,p1[r],p1[r+1]);b=max3f(b,p1[r+2],p1[r+3]);}
  const float m=max2f(a,b);
  auto rr=__builtin_amdgcn_permlane32_swap(__float_as_uint(m),__float_as_uint(m),false,false);
  return max2f(__uint_as_float(rr[0]),__uint_as_float(rr[1]));
}
__device__ __forceinline__ void pv(f32x16*o,int vb,bf16x8 pa0,bf16x8 pa1,bf16x8 pa2,bf16x8 pa3){
  #pragma unroll
  for(int d0=0;d0<2;++d0){s16x4 lo[4],hi[4];
    #pragma unroll
    for(int ks=0;ks<4;++ks){
      asm volatile("ds_read_b64_tr_b16 %0,%1 offset:%c2":"=&v"(lo[ks]):"v"(vb),"i"(d0*4096+ks*1024):"memory");
      asm volatile("ds_read_b64_tr_b16 %0,%1 offset:%c2":"=&v"(hi[ks]):"v"(vb),"i"(d0*4096+ks*1024+512):"memory");}
    asm volatile("s_waitcnt lgkmcnt(0)":::"memory");SBAR();
    #define PK(k) (bf16x8){lo[k][0],lo[k][1],lo[k][2],lo[k][3],hi[k][0],hi[k][1],hi[k][2],hi[k][3]}
    o[d0]=__builtin_amdgcn_mfma_f32_32x32x16_bf16(pa0,PK(0),o[d0],0,0,0);
    o[d0]=__builtin_amdgcn_mfma_f32_32x32x16_bf16(pa1,PK(1),o[d0],0,0,0);
    o[d0]=__builtin_amdgcn_mfma_f32_32x32x16_bf16(pa2,PK(2),o[d0],0,0,0);
    o[d0]=__builtin_amdgcn_mfma_f32_32x32x16_bf16(pa3,PK(3),o[d0],0,0,0);
    #undef PK
  }
}

#ifndef ATTN_STORE16
#define ATTN_STORE16(p,v) (*(u32x4*)(p)=(v))
#endif
template<int THRL> __device__ __forceinline__ void attn_unit(int b,int qb,const bf16*Q,const bf16*__restrict__ K,const bf16*__restrict__ V,bf16*O,char*shm,const float a2,const int t0,const float mref,bf16x8(&qr)[4],const bool pre,const bool hasnext,const int qbn,const bf16*Qn,const bf16*Kn,const int t0n){
  int tid_=threadIdx.x; asm volatile("":"+v"(tid_));
  const int tid=tid_,lane=tid&63,r32=lane&31,hi=lane>>5; const int wid=__builtin_amdgcn_readfirstlane(tid>>6);
  const long rowbase=(long)b*SEQ; const int q0=qb*QB;
  const bf16*Qw=Q+(rowbase+q0+wid*QBLK)*DM;
  const bf16*Kh=K+(rowbase+(long)t0*KVBLK)*DM,*Vh=V+(rowbase+(long)t0*KVBLK)*DM;
  const unsigned lds0=(unsigned)(uintptr_t)shm;
  float*wsf=(float*)(shm+LDS_WS)+wid*64;
  const bf16*ksrc=Kh+(long)lane*DM+wid*8;
  const bf16*vsrc=Vh+(long)(16*(wid&3)+(lane>>2))*DM+(wid>>2)*32+(lane&3)*8;
  const unsigned kdst=lds0+LDS_K+wid*1024, vdst=lds0+LDS_V+wid*1024;
  #define DMA_K(t,slot) glds16(ksrc+(long)(t)*KVBLK*DM,(unsigned)__builtin_amdgcn_readfirstlane(kdst+(slot)))
  #define DMA_V(t,slot) glds16(vsrc+(long)(t)*KVBLK*DM,(unsigned)__builtin_amdgcn_readfirstlane(vdst+(slot)))
  const int vb0=(int)(lds0+LDS_V)+((lane>>4)&1)*32+(lane&3)*8+(4*hi+((lane&15)>>2))*64;
  const char*Kbase=shm+LDS_K; bf16x8 kf[8];
  const lds_cptr shm3=(lds_cptr)shm; const lds_cptr kp0=shm3+LDS_K+hi*1024+r32*16; const lds_cptr vp0=shm3+LDS_V+((lane>>4)&1)*32+(lane&3)*8+(4*hi+((lane&15)>>2))*64;
  const int NT=(q0+QB)/KVBLK-t0;
  if(!pre){ DMA_K(0,0);DMA_K(1,SLOTB);DMA_K(2,2*SLOTB); }
  if(!pre){
  #pragma unroll
  for(int d0=0;d0<4;++d0)qr[d0]=*reinterpret_cast<const bf16x8*>(&Qw[(long)r32*DM+d0*16+hi*8]); }
  DMA_V(0,0);
  float l_reg=0.f;f32x16 o[2];o[0]=f32x16{};o[1]=f32x16{};
  float sl; { float hb_=(float)(4*hi-(q0+wid*QBLK+r32-64*t0)); asm volatile("":"+v"(hb_)); sl=a2*hb_-mref; }
  float KR[16];
  _Pragma("unroll") for(int r=0;r<16;++r){ const float kv_=a2*(float)((r&3)+8*(r>>2)); asm volatile("s_nop 1\n\tv_readfirstlane_b32 %0, %1":"=s"(KR[r]):"v"(kv_)); }
  const float a64=64.f*a2,a32=32.f*a2;
  #define SADD(d,s,v) asm("v_add_f32_e32 %0, %1, %2":"=v"(d):"s"(s),"v"(v))
  #define INITC(X0,X1) do{ sl+=a64; const float sl2_=sl+a32; _Pragma("unroll") for(int r=0;r<16;++r){ float x0_,x1_; SADD(x0_,KR[r],sl); SADD(x1_,KR[r],sl2_); X0[r]=x0_; X1[r]=x1_; } asm volatile("":"+v"(X0),"+v"(X1)); }while(0)
  #define ADD32(P1) do{ _Pragma("unroll") for(int r=0;r<16;++r)P1[r]+=a32; }while(0)
  const int qrel=wid*QBLK+r32;
  #define CMASK(P0,P1,t) do{int jb_=(t)-(NT-4); if(jb_>=0)cmask(P0,P1,jb_,qrel,hi);}while(0)
  bool resc=false;
  #define START(P0,P1) do{ _Pragma("unroll") for(int r=0;r<16;++r)P0[r]=__builtin_amdgcn_exp2f(P0[r]); }while(0)
  #define RESC() do{ if(resc){ asm volatile("s_waitcnt lgkmcnt(0)":::"memory"); \
      _Pragma("unroll") for(int d_=0;d_<2;++d_) _Pragma("unroll") for(int r=0;r<16;++r)o[d_][r]*=wsf[crow(r,hi)]; } }while(0)
  f32x16 pA0,pA1,pB0,pB1;
  int sl_prev=0,sl_cur=0,sl_next=SLOTB;
  #define ROT() do{sl_prev=sl_cur;sl_cur=sl_next;sl_next=(sl_next==(NSLOT-1)*SLOTB)?0:sl_next+SLOTB;}while(0)
  WAIT_BAR(1);
  { f32x16 c0_; _Pragma("unroll") for(int r=0;r<16;++r){ float x_; SADD(x_,KR[r],sl); c0_[r]=x_; } asm volatile("s_nop 1":"+v"(c0_));
    qkt(pA0,pA1,Kbase,qr,c0_,r32,hi); }
  asm volatile("s_nop 15\n\ts_nop 7":"+v"(pA0),"+v"(pA1));ADD32(pA1);CMASK(pA0,pA1,0);
  START(pA0,pA1);
  _Pragma("unroll") for(int r=0;r<16;++r)pA1[r]=__builtin_amdgcn_exp2f(pA1[r]);
  WAIT_BAR(0);
  DMA_K(3,0);DMA_V(1,SLOTB);
  ROT();
  kload8(kf,kp0+sl_cur);
  WAIT_BAR(2);
  s16x4 vlo[8],vhi[8]; u32x4 pw0,pw1,pw2,pw3;
  #define PKW(P,B) cvtpk_s(P[B],P[B+1])
  #define PAF(k) __builtin_bit_cast(bf16x8,pw##k)
  #define VFR(i) (bf16x8){vlo[i][0],vlo[i][1],vlo[i][2],vlo[i][3],vhi[i][0],vhi[i][1],vhi[i][2],vhi[i][3]}
  #define PIN(x) asm volatile("":"+v"(x))
  #define MX3(a,b,c) __builtin_fmaxf(__builtin_fmaxf((a),(b)),(c))
  #define GAPA(MF,A0,A1,A2,A3,W0,W1,PW) do{ MF; sacc+=A0; sacc+=A1; sacc+=A2; sacc+=A3; PIN(sacc); W0; W1; PIN(PW); SBAR(); }while(0)
  #define EX(v) __builtin_amdgcn_exp2f(v)
  #define GAPB(MF,X,B) do{ MF; PIN(o[0]); PIN(o[1]); X[B]=EX(X[B]); X[B+1]=EX(X[B+1]); X[B+2]=EX(X[B+2]); X[B+3]=EX(X[B+3]); PIN(X); SBAR(); }while(0)
  #define VRD(i) do{ vlo[i]=vtr(vp_+(((i)>>2)*4096+((i)&3)*1024)); vhi[i]=vtr(vp_+(((i)>>2)*4096+((i)&3)*1024+512)); }while(0)
  #define KRD(G,j) do{ if(G){ kload2(kf,kp0+sl_next,j); SBAR(); } }while(0)
  #define STEP(C0,C1,P0,P1,t,GK,GV,GL) do{ SBAR(); INITC(C0,C1); SBAR(); \
    const lds_cptr vp_=vp0+sl_prev; \
    VRD(0); SBAR(); float sacc=(P0[0]+P0[1]); \
    GAPA(C0=__builtin_amdgcn_mfma_f32_32x32x16_bf16(kf[0],qr[0],C0,0,0,0), P0[2],P0[3],P0[4],P0[5],     pw0[0]=PKW(P0,0), pw0[1]=PKW(P0,2), pw0); \
    VRD(4); SBAR(); GAPA(C1=__builtin_amdgcn_mfma_f32_32x32x16_bf16(kf[1],qr[0],C1,0,0,0), P0[6],P0[7],P0[8],P0[9],     pw0[2]=PKW(P0,4), pw0[3]=PKW(P0,6), pw0); \
    VRD(1); SBAR(); GAPA(C0=__builtin_amdgcn_mfma_f32_32x32x16_bf16(kf[2],qr[1],C0,0,0,0),   P0[10],P0[11],P0[12],P0[13], pw1[0]=PKW(P0,8), pw1[1]=PKW(P0,10), pw1); \
    VRD(5); SBAR(); GAPA(C1=__builtin_amdgcn_mfma_f32_32x32x16_bf16(kf[3],qr[1],C1,0,0,0),   P0[14],P0[15],P1[0],P1[1],   pw1[2]=PKW(P0,12),pw1[3]=PKW(P0,14), pw1); \
    VRD(2); SBAR(); GAPA(C0=__builtin_amdgcn_mfma_f32_32x32x16_bf16(kf[4],qr[2],C0,0,0,0),   P1[2],P1[3],P1[4],P1[5],     pw2[0]=PKW(P1,0), pw2[1]=PKW(P1,2), pw2); \
    VRD(6); SBAR(); GAPA(C1=__builtin_amdgcn_mfma_f32_32x32x16_bf16(kf[5],qr[2],C1,0,0,0),   P1[6],P1[7],P1[8],P1[9],     pw2[2]=PKW(P1,4), pw2[3]=PKW(P1,6), pw2); \
    VRD(3); SBAR(); GAPA(C0=__builtin_amdgcn_mfma_f32_32x32x16_bf16(kf[6],qr[3],C0,0,0,0),   P1[10],P1[11],P1[12],P1[13], pw3[0]=PKW(P1,8), pw3[1]=PKW(P1,10), pw3); \
    VRD(7); SBAR(); GAPA(C1=__builtin_amdgcn_mfma_f32_32x32x16_bf16(kf[7],qr[3],C1,0,0,0),   P1[14],P1[15],0.f,0.f,       pw3[2]=PKW(P1,12),pw3[3]=PKW(P1,14), pw3); \
    l_reg+=sacc; \
    if(GK){DMA_K((t)+3,sl_cur);} if(GV){DMA_V((t)+1,sl_next);} \
    CMASK(C0,C1,t); SBAR(); \
    GAPB(o[0]=__builtin_amdgcn_mfma_f32_32x32x16_bf16(PAF(0),VFR(0),o[0],0,0,0), C0,0); \
    GAPB(o[1]=__builtin_amdgcn_mfma_f32_32x32x16_bf16(PAF(0),VFR(4),o[1],0,0,0), C0,4); \
    KRD(GL,0); GAPB(o[0]=__builtin_amdgcn_mfma_f32_32x32x16_bf16(PAF(1),VFR(1),o[0],0,0,0), C0,8); \
    KRD(GL,1); GAPB(o[1]=__builtin_amdgcn_mfma_f32_32x32x16_bf16(PAF(1),VFR(5),o[1],0,0,0), C0,12); \
    KRD(GL,2); GAPB(o[0]=__builtin_amdgcn_mfma_f32_32x32x16_bf16(PAF(2),VFR(2),o[0],0,0,0), C1,0); \
    KRD(GL,3); GAPB(o[1]=__builtin_amdgcn_mfma_f32_32x32x16_bf16(PAF(2),VFR(6),o[1],0,0,0), C1,4); \
    GAPB(o[0]=__builtin_amdgcn_mfma_f32_32x32x16_bf16(PAF(3),VFR(3),o[0],0,0,0), C1,8); \
    GAPB(o[1]=__builtin_amdgcn_mfma_f32_32x32x16_bf16(PAF(3),VFR(7),o[1],0,0,0), C1,12); \
    }while(0)
  int t=1;
  #undef CMASK
  #define CMASK(P0,P1,t) do{}while(0)
  for(;t+5<NT;t+=2){
    STEP(pB0,pB1,pA0,pA1,t,true,true,true);     WAIT_BAR(2); RESC(); ROT();
    STEP(pA0,pA1,pB0,pB1,t+1,true,true,true);   WAIT_BAR(2); RESC(); ROT();
  }
  #undef CMASK
  #define CMASK(P0,P1,t) do{int jb_=(t)-(NT-4); if(jb_>=0)cmask(P0,P1,jb_,qrel,hi);}while(0)
  #define ENDW(tt) do{ if((tt)+3<NT){WAIT_BAR(2);} else if((tt)+2<NT){WAIT_BAR(1);} else {WAIT_BAR(0);} }while(0)
  for(;t+1<NT;t+=2){
    STEP(pB0,pB1,pA0,pA1,t,(t+3<NT),(t+1<NT),(t+1<NT));       ENDW(t);   RESC(); ROT();
    STEP(pA0,pA1,pB0,pB1,t+1,(t+4<NT),(t+2<NT),(t+2<NT));     ENDW(t+1); RESC(); ROT();
  }
  STEP(pB0,pB1,pA0,pA1,NT-1,false,false,false); RESC();
  if(hasnext){ const bf16*ksn=Kn+(rowbase+(long)t0n*KVBLK)*DM+(long)lane*DM+wid*8; const bf16*Qwn=Qn+(rowbase+(long)qbn*QB+wid*QBLK)*DM;
    glds16(ksn,(unsigned)__builtin_amdgcn_readfirstlane(kdst)); glds16(ksn+(long)KVBLK*DM,(unsigned)__builtin_amdgcn_readfirstlane(kdst+SLOTB)); glds16(ksn+2L*KVBLK*DM,(unsigned)__builtin_amdgcn_readfirstlane(kdst+2*SLOTB));
    _Pragma("unroll") for(int d0=0;d0<4;++d0)qr[d0]=*reinterpret_cast<const bf16x8*>(&Qwn[(long)r32*DM+d0*16+hi*8]); }
  { float sacc=pB0[0]+pB0[1]; _Pragma("unroll") for(int r=2;r<16;++r)sacc+=pB0[r]; _Pragma("unroll") for(int r=0;r<16;++r)sacc+=pB1[r]; l_reg+=sacc;
    pw0=(u32x4){PKW(pB0,0),PKW(pB0,2),PKW(pB0,4),PKW(pB0,6)};pw1=(u32x4){PKW(pB0,8),PKW(pB0,10),PKW(pB0,12),PKW(pB0,14)};pw2=(u32x4){PKW(pB1,0),PKW(pB1,2),PKW(pB1,4),PKW(pB1,6)};pw3=(u32x4){PKW(pB1,8),PKW(pB1,10),PKW(pB1,12),PKW(pB1,14)};
    SBAR(); pv(o,vb0+sl_cur,PAF(0),PAF(1),PAF(2),PAF(3)); }
  #undef PKW
  #undef PAF
  #undef VFR
  #undef PIN
  #undef MX3
  #undef GAPA
  #undef GAPB
  #undef EX
  #undef VRD
  #undef KRD
  #undef STEP
  #undef ENDW
  {auto rr=__builtin_amdgcn_permlane32_swap(__float_as_uint(l_reg),__float_as_uint(l_reg),false,false);l_reg=__uint_as_float(rr[0])+__uint_as_float(rr[1]);}
  if(hi==0)wsf[32+r32]=l_reg;asm volatile("s_waitcnt lgkmcnt(0)":::"memory");
  float rli[16];
  #pragma unroll
  for(int r=0;r<16;++r)rli[r]=__builtin_amdgcn_rcpf(wsf[32+crow(r,hi)]);
  bf16*Ow=O+(rowbase+q0+wid*QBLK)*DM;
  { bf16*stg=(bf16*)(shm+LDS_OST)+wid*2048;
    #pragma unroll
    for(int r=0;r<16;++r){const int orow=crow(r,hi);
      #pragma unroll
      for(int d0=0;d0<2;++d0)stg[orow*64+d0*32+r32]=__float2bfloat16(o[d0][r]*rli[r]);}
    asm volatile("s_waitcnt lgkmcnt(0)":::"memory");
    #pragma unroll
    for(int i=0;i<4;++i){const int row=i*8+(lane>>3),ch=lane&7; const u32x4 v=*(const u32x4*)(stg+row*64+ch*8); ATTN_STORE16(Ow+(long)row*DM+ch*8,v);} }
  asm volatile("s_waitcnt lgkmcnt(0)\n\ts_barrier":::"memory");
  #undef INITC
  #undef SADD
  #undef ADD32
  #undef DMA_K
  #undef DMA_V
  #undef CMASK
  #undef START
  #undef RESC
  #undef ROT
}

constexpr int ATTN_LDS_BYTES=LDS_BYTES;
#undef SBAR
#undef WAIT_BAR
}
__device__ __forceinline__ float lam_value(const float* q1, const float* k1, const float* q2, const float* k2, int lane) {
    const float a = wave_sum(q1[lane] * k1[lane]), b = wave_sum(q2[lane] * k2[lane]);
    return __expf(a) - __expf(b) + LAM0;
}
template <int NR>
__device__ __forceinline__ void combine_rows(const bf16* O0, const bf16* O1, bf16* MIX, const float* sg, float lam, int row, int stride, int lane) {
    u32x4 a[NR], b[NR];
#pragma unroll
    for (int k = 0; k < NR; ++k) { a[k] = *(const u32x4*)(O0 + (size_t)(row + k * stride) * 512 + 8 * lane); b[k] = *(const u32x4*)(O1 + (size_t)(row + k * stride) * 512 + 8 * lane); }
    const f32x4 g0 = *(const f32x4*)(sg + (8 * lane & 127)), g1 = *(const f32x4*)(sg + (8 * lane & 127) + 4);
#pragma unroll
    for (int k = 0; k < NR; ++k) { float v[8]; float s = 0.f;
#pragma unroll
        for (int i = 0; i < 4; ++i) { v[2 * i] = bflo(a[k][i]) - lam * bflo(b[k][i]); v[2 * i + 1] = bfhi(a[k][i]) - lam * bfhi(b[k][i]); s += v[2 * i] * v[2 * i] + v[2 * i + 1] * v[2 * i + 1]; }
        s = row_allsum(s);
        const float rinv = (1.f - LAM0) / sqrtf(s * (1.f / VD) + EPS);
        u32x4 o; o.x = pk2(v[0] * rinv * g0[0], v[1] * rinv * g0[1]); o.y = pk2(v[2] * rinv * g0[2], v[3] * rinv * g0[3]);
        o.z = pk2(v[4] * rinv * g1[0], v[5] * rinv * g1[1]); o.w = pk2(v[6] * rinv * g1[2], v[7] * rinv * g1[3]);
        *(u32x4*)(MIX + (size_t)(row + k * stride) * 1024 + 512 + 8 * lane) = o; }
}
constexpr int SA_SC = 0, SA_PL = 16384, SA_ACC = 32768, SA_ML = 98304, SA_FIN = 99328;
__device__ __forceinline__ void sattn_unit(const bf16* Qb, const bf16* Kb, const bf16* Vb, const float* ck, const float* cv, const int* pt, bf16* MIX, const float* sg, float lam,
                                           int s, int h, int c0, LAS unsigned char* lds, int tid_in) {
    int tid = tid_in; asm volatile("" : "+v"(tid));
    const int lane = tid & 63, w = __builtin_amdgcn_readfirstlane(tid >> 6);
    const float slope2 = exp2f(-2.f * (float)(h + 1)) * LOG2E;
    LAS float* sc = (LAS float*)(lds + SA_SC) + w * 512;
    LAS float* pl = (LAS float*)(lds + SA_PL) + w * 512;
    LAS float* accm = (LAS float*)(lds + SA_ACC);
    LAS float* ml = (LAS float*)(lds + SA_ML);
    LAS float* fin = (LAS float*)(lds + SA_FIN);
    const int r32 = lane & 31, hi = lane >> 5;
    bf16x8 qf[2][4];
#pragma unroll
    for (int mp = 0; mp < 2; ++mp)
#pragma unroll
        for (int ks = 0; ks < 4; ++ks) qf[mp][ks] = *(const bf16x8*)(Qb + (size_t)(MP + 4 * s + (r32 & 3)) * 512 + h * 128 + mp * 64 + 16 * ks + 8 * hi);
    float mrun[8], lrun[8], acc[8][4];
#pragma unroll
    for (int c = 0; c < 8; ++c) { mrun[c] = -INFINITY; lrun[c] = 0.f; acc[c][0] = 0.f; acc[c][1] = 0.f; acc[c][2] = 0.f; acc[c][3] = 0.f; }
    for (int chunk = c0 + w; chunk < 32; chunk += 8) {
        const int page = pt[s * NPAGES + (chunk >> 1)];
        const size_t tok0 = (size_t)page * PAGE + (chunk & 1) * 64;
        const int kp0 = 64 * chunk;
#pragma unroll
        for (int mp = 0; mp < 2; ++mp) {
            f32x4 kk[2][4][2];
#pragma unroll
            for (int kb = 0; kb < 2; ++kb)
#pragma unroll
                for (int ks = 0; ks < 4; ++ks) { const float* kp = ck + ((tok0 + kb * 32 + r32) * NH + h) * 128 + mp * 64 + 16 * ks + 8 * hi;
                    kk[kb][ks][0] = *(const f32x4*)kp; kk[kb][ks][1] = *(const f32x4*)(kp + 4); }
            asm volatile("s_waitcnt vmcnt(0)" ::: "memory");
#pragma unroll
            for (int kb = 0; kb < 2; ++kb) { f32x16 sa = {};
#pragma unroll
                for (int ks = 0; ks < 4; ++ks) { const u32x4 kw = ep::pack8(kk[kb][ks][0], kk[kb][ks][1]);
                    sa = __builtin_amdgcn_mfma_f32_32x32x16_bf16(__builtin_bit_cast(bf16x8, kw), qf[mp][ks], sa, 0, 0, 0); }
                if (r32 < 4) {
#pragma unroll
                    for (int r = 0; r < 16; ++r) sc[(mp * 4 + r32) * 64 + kb * 32 + (r & 3) + 8 * (r >> 2) + 4 * hi] = sa[r]; } }
        }
        LDS_WAIT(); asm volatile("" ::: "memory");
#pragma unroll
        for (int c = 0; c < 8; ++c) { const int t = c & 3;
            const float sv = sc[c * 64 + lane] - slope2 * (float)(PAST + t - (kp0 + lane));
            const float mn = __builtin_bit_cast(float, __builtin_amdgcn_readfirstlane(__builtin_bit_cast(int, fmaxf(mrun[c], wave_max(sv))))); const float p = __builtin_amdgcn_exp2f(sv - mn);
            const float fsc_ = __builtin_amdgcn_exp2f(mrun[c] - mn); lrun[c] = __builtin_bit_cast(float, __builtin_amdgcn_readfirstlane(__builtin_bit_cast(int, lrun[c] * fsc_ + wave_sum(p)))); mrun[c] = mn; pl[lane * 8 + c] = p; acc[c][0] *= fsc_; acc[c][1] *= fsc_; acc[c][2] *= fsc_; acc[c][3] *= fsc_; }
        LDS_WAIT(); asm volatile("" ::: "memory");
        const float* vp = cv + ((tok0 + hi) * NH + h) * 128 + 4 * r32;
#pragma unroll 1
        for (int k0 = 0; k0 < 64; k0 += 16) { f32x4 vv[8];
#pragma unroll
            for (int k = 0; k < 8; ++k) vv[k] = *(const f32x4*)(vp + (size_t)(k0 + 2 * k) * NH * 128);
            asm volatile("s_waitcnt vmcnt(0)" ::: "memory");
#pragma unroll
            for (int k = 0; k < 8; ++k) { const f32x4 v4 = vv[k]; const LAS float* pp = pl + (k0 + 2 * k + hi) * 8; const f32x4 p0 = *(const LAS f32x4*)pp, p1 = *(const LAS f32x4*)(pp + 4);
#pragma unroll
                for (int c = 0; c < 4; ++c)
#pragma unroll
                    for (int i = 0; i < 4; ++i) { acc[c][i] += p0[c] * v4[i]; acc[4 + c][i] += p1[c] * v4[i]; } } }
        LDS_WAIT(); asm volatile("" ::: "memory");
    }
#pragma unroll
    for (int c = 0; c < 8; ++c) { *(LAS f32x4*)(accm + ((2 * w + hi) * 8 + c) * 128 + 4 * r32) = (f32x4){acc[c][0], acc[c][1], acc[c][2], acc[c][3]}; }
    if (lane == 0) {
#pragma unroll
        for (int c = 0; c < 8; ++c) { ml[w * 8 + c] = mrun[c]; ml[64 + w * 8 + c] = lrun[c]; } }
    __syncthreads();
    { const int map = w >> 2, t = w & 3;
      const float q = bf2f(Qb[(size_t)(MP + 4 * s + t) * 512 + h * 128 + map * 64 + lane]);
      float sn[4];
#pragma unroll
      for (int t2 = 0; t2 < 4; ++t2) { const float kk = bf2f(Kb[(size_t)(MP + 4 * s + t2) * 512 + h * 128 + map * 64 + lane]); sn[t2] = wave_sum(q * kk) - slope2 * (float)(t - t2); if (t2 > t) sn[t2] = -INFINITY; }
      float M = fmaxf(fmaxf(sn[0], sn[1]), fmaxf(sn[2], sn[3]));
#pragma unroll
      for (int w2 = 0; w2 < 8; ++w2) M = fmaxf(M, ml[w2 * 8 + w]);
      float L = 0.f, o0 = 0.f, o1 = 0.f;
#pragma unroll
      for (int w2 = 0; w2 < 8; ++w2) { const float f = __builtin_amdgcn_exp2f(ml[w2 * 8 + w] - M); L += ml[64 + w2 * 8 + w] * f;
          const f32x2 a = *(const LAS f32x2*)(accm + ((2 * w2) * 8 + w) * 128 + 2 * lane), b2 = *(const LAS f32x2*)(accm + ((2 * w2 + 1) * 8 + w) * 128 + 2 * lane); o0 += (a[0] + b2[0]) * f; o1 += (a[1] + b2[1]) * f; }
#pragma unroll
      for (int t2 = 0; t2 < 4; ++t2) { const float p = __builtin_amdgcn_exp2f(sn[t2] - M); L += p; const unsigned vv = *(const unsigned*)(Vb + (size_t)(MP + 4 * s + t2) * 512 + h * 128 + 2 * lane); o0 += p * bflo(vv); o1 += p * bfhi(vv); }
      const float rl = 1.f / L;
      *(LAS f32x2*)(fin + w * 128 + 2 * lane) = (f32x2){o0 * rl, o1 * rl}; }
    __syncthreads();
    if (w < 4) { const f32x2 a = *(const LAS f32x2*)(fin + w * 128 + 2 * lane), b = *(const LAS f32x2*)(fin + (4 + w) * 128 + 2 * lane);
        const float v0 = a[0] - lam * b[0], v1 = a[1] - lam * b[1]; const float ss = wave_sum(v0 * v0 + v1 * v1);
        const float rinv = (1.f - LAM0) / sqrtf(ss * (1.f / VD) + EPS);
        *(unsigned*)(MIX + (size_t)(MP + 4 * s + w) * 1024 + 512 + h * 128 + 2 * lane) = pk2(v0 * rinv * sg[2 * lane], v1 * rinv * sg[2 * lane + 1]); }
    __syncthreads();
}
constexpr int XS_SC = 0, XS_P = 4096, XS_ACC = 8192;
__device__ __forceinline__ void xattn_sample_unit(const bf16* CQ, const float* SSQ, const float* cmk, const float* cmv, bf16* CO, int s, int h, LAS unsigned char* lds, int tid) {
    const int lane = tid & 63, w = __builtin_amdgcn_readfirstlane(tid >> 6);
    LAS float* scx = (LAS float*)(lds + XS_SC); LAS float* px = (LAS float*)(lds + XS_P); LAS float* accx = (LAS float*)(lds + XS_ACC);
    { const int r32 = lane & 31, hi = lane >> 5, t = r32 & 3;
      const f32x4 pq = *(const f32x4*)(SSQ + (size_t)(4 * s + t) * 16 + 4 * h); const float qs = 1.f / sqrtf(((pq[0] + pq[1]) + (pq[2] + pq[3])) * (1.f / 256.f) + EPS);
      const float* kp = cmk + (((size_t)s * NMEM + 32 * w + r32) * CAH + h) * CAD + 8 * hi; const bf16* qp = CQ + (size_t)(MP + 4 * s + t) * 1024 + h * 256 + 8 * hi;
      f32x16 sa = {};
      { f32x4 kk[16][2]; bf16x8 qf[16];
#pragma unroll
        for (int ks = 0; ks < 16; ++ks) { kk[ks][0] = *(const f32x4*)(kp + 16 * ks); kk[ks][1] = *(const f32x4*)(kp + 16 * ks + 4); qf[ks] = *(const bf16x8*)(qp + 16 * ks); }
        asm volatile("" ::: "memory");
#pragma unroll
        for (int ks = 0; ks < 16; ++ks) { const u32x4 kw = ep::pack8(kk[ks][0], kk[ks][1]); sa = __builtin_amdgcn_mfma_f32_32x32x16_bf16(__builtin_bit_cast(bf16x8, kw), qf[ks], sa, 0, 0, 0); } }
      if (r32 < 4) {
#pragma unroll
          for (int r = 0; r < 16; ++r) scx[r32 * 256 + 32 * w + (r & 3) + 8 * (r >> 2) + 4 * hi] = sa[r] * qs; } }
    f32x4 vv[32];
    { const float* vb = cmv + (((size_t)s * NMEM + 32 * w) * CAH + h) * CAD + 4 * lane;
#pragma unroll
      for (int j = 0; j < 32; ++j) vv[j] = *(const f32x4*)(vb + (size_t)j * CAH * CAD);
      asm volatile("" ::: "memory"); }
    asm volatile("s_waitcnt lgkmcnt(0)\n\ts_barrier" ::: "memory");
    if (w < 4) { float sv[4]; float mx = -INFINITY;
#pragma unroll
        for (int j = 0; j < 4; ++j) { sv[j] = scx[w * 256 + lane + 64 * j]; mx = fmaxf(mx, sv[j]); }
        mx = wave_max(mx); float sum = 0.f;
#pragma unroll
        for (int j = 0; j < 4; ++j) { sv[j] = __builtin_amdgcn_exp2f(sv[j] - mx); sum += sv[j]; }
        const float rl = 1.f / wave_sum(sum);
#pragma unroll
        for (int j = 0; j < 4; ++j) px[w * 256 + lane + 64 * j] = sv[j] * rl; }
    asm volatile("s_waitcnt lgkmcnt(0)\n\ts_barrier" ::: "memory");
    { float acc[4][4];
#pragma unroll
      for (int t = 0; t < 4; ++t)
#pragma unroll
          for (int i = 0; i < 4; ++i) acc[t][i] = 0.f;
#pragma unroll
      for (int j = 0; j < 32; ++j) { const f32x4 v = vv[j];
#pragma unroll
          for (int t = 0; t < 4; ++t) { const float p = px[t * 256 + 32 * w + j];
#pragma unroll
              for (int i = 0; i < 4; ++i) acc[t][i] += p * v[i]; } }
#pragma unroll
      for (int t = 0; t < 4; ++t) *(LAS f32x4*)(accx + (w * 4 + t) * 256 + 4 * lane) = (f32x4){acc[t][0], acc[t][1], acc[t][2], acc[t][3]}; }
    __syncthreads();
    { const int t = tid >> 7, dv = (tid & 127) * 2; float o0 = 0.f, o1 = 0.f;
#pragma unroll
      for (int w2 = 0; w2 < 8; ++w2) { const f32x2 a = *(const LAS f32x2*)(accx + (w2 * 4 + t) * 256 + dv); o0 += a[0]; o1 += a[1]; }
      *(unsigned*)(CO + (size_t)(MP + 4 * s + t) * 1024 + h * 256 + dv) = pk2(o0, o1); }
    __syncthreads();
}
constexpr int XP_KP = 528, XP_VP = 320, XP_K = 0, XP_V = 64 * XP_KP, XP_F = XP_V + 64 * XP_VP;
typedef short v4i16_t __attribute__((ext_vector_type(4)));
__device__ __forceinline__ void xattn_prompt_unit(const bf16* CQ, const bf16* MKb, const bf16* MVb, bf16* CO, int rt, int h, int dvh, LAS unsigned char* lds, int tid) {
    const int lane = tid & 63, w = __builtin_amdgcn_readfirstlane(tid >> 6), r32 = lane & 31, hi = lane >> 5, b = rt >> 4;
    LAS unsigned char* Kt = lds + XP_K; LAS unsigned char* Vt = lds + XP_V; LAS float* fsc = (LAS float*)(lds + XP_F) + w * 32;
    bf16x8 qf[16];
    { const bf16* qp = CQ + (size_t)(256 * rt + 32 * w + r32) * 1024 + h * 256 + 8 * hi;
#pragma unroll
      for (int ds = 0; ds < 16; ++ds) qf[ds] = *(const bf16x8*)(qp + 16 * ds); }
    f32x16 o[4]; o[0] = f32x16{}; o[1] = f32x16{}; o[2] = f32x16{}; o[3] = f32x16{};
    float mrow = -INFINITY, lrow = 0.f;
    for (int kt = 0; kt < 4; ++kt) {
        const size_t krow0 = (size_t)b * NMEM + 64 * kt;
#pragma unroll
        for (int it = 0; it < 4; ++it) { const int idx = tid + 512 * it, key = idx >> 5, c = idx & 31;
            *(LAS u32x4*)(Kt + key * XP_KP + c * 16) = *(const u32x4*)(MKb + (krow0 + key) * 1024 + h * 256 + c * 8); }
#pragma unroll
        for (int it = 0; it < 2; ++it) { const int idx = tid + 512 * it, key = idx >> 4, c = idx & 15;
            *(LAS u32x4*)(Vt + key * XP_VP + c * 16) = *(const u32x4*)(MVb + (krow0 + key) * 1024 + h * 256 + dvh * 128 + c * 8); }
        __syncthreads();
        f32x16 p0 = f32x16{}, p1 = f32x16{};
#pragma unroll
        for (int ds = 0; ds < 16; ++ds) { const bf16x8 k0 = *(const LAS bf16x8*)(Kt + r32 * XP_KP + (16 * ds + 8 * hi) * 2), k1 = *(const LAS bf16x8*)(Kt + (32 + r32) * XP_KP + (16 * ds + 8 * hi) * 2);
            p0 = __builtin_amdgcn_mfma_f32_32x32x16_bf16(k0, qf[ds], p0, 0, 0, 0); p1 = __builtin_amdgcn_mfma_f32_32x32x16_bf16(k1, qf[ds], p1, 0, 0, 0); }
        float mx = fmaxf(p0[0], p1[0]);
#pragma unroll
        for (int r = 1; r < 16; ++r) mx = fmaxf(mx, fmaxf(p0[r], p1[r]));
        mx = fmaxf(mx, __shfl_xor(mx, 32));
        const float mn = fmaxf(mrow, mx), f = __builtin_amdgcn_exp2f(mrow - mn); mrow = mn;
        float ls = 0.f;
#pragma unroll
        for (int r = 0; r < 16; ++r) { p0[r] = __builtin_amdgcn_exp2f(p0[r] - mn); p1[r] = __builtin_amdgcn_exp2f(p1[r] - mn); ls += p0[r] + p1[r]; }
        lrow = lrow * f + ls;
        if (hi == 0) fsc[r32] = f;
        LDS_WAIT(); asm volatile("" ::: "memory");
#pragma unroll
        for (int r = 0; r < 16; ++r) { const float fr_ = fsc[(r & 3) + 8 * (r >> 2) + 4 * hi];
#pragma unroll
            for (int d = 0; d < 4; ++d) o[d][r] *= fr_; }
        u32x4 pa[2][2];
#pragma unroll
        for (int s2 = 0; s2 < 2; ++s2) { pa[0][s2] = (u32x4){pg8::cvt_pk_bf16(p0[8 * s2], p0[8 * s2 + 1]), pg8::cvt_pk_bf16(p0[8 * s2 + 2], p0[8 * s2 + 3]), pg8::cvt_pk_bf16(p0[8 * s2 + 4], p0[8 * s2 + 5]), pg8::cvt_pk_bf16(p0[8 * s2 + 6], p0[8 * s2 + 7])};
            pa[1][s2] = (u32x4){pg8::cvt_pk_bf16(p1[8 * s2], p1[8 * s2 + 1]), pg8::cvt_pk_bf16(p1[8 * s2 + 2], p1[8 * s2 + 3]), pg8::cvt_pk_bf16(p1[8 * s2 + 4], p1[8 * s2 + 5]), pg8::cvt_pk_bf16(p1[8 * s2 + 6], p1[8 * s2 + 7])}; }
        const LAS unsigned char* vb = Vt + (4 * hi + ((lane & 15) >> 2)) * XP_VP + (16 * ((lane >> 4) & 1) + 4 * (lane & 3)) * 2;
#pragma unroll
        for (int d = 0; d < 4; ++d)
#pragma unroll
            for (int kb = 0; kb < 2; ++kb)
#pragma unroll
                for (int s2 = 0; s2 < 2; ++s2) { const LAS unsigned char* p = vb + (32 * kb + 16 * s2) * XP_VP + d * 64;
                    const v4i16_t lo = __builtin_amdgcn_ds_read_tr16_b64_v4i16((LAS v4i16_t*)p), hh = __builtin_amdgcn_ds_read_tr16_b64_v4i16((LAS v4i16_t*)(p + 8 * XP_VP));
                    const bf16x8 vf = (bf16x8){lo[0], lo[1], lo[2], lo[3], hh[0], hh[1], hh[2], hh[3]};
                    o[d] = __builtin_amdgcn_mfma_f32_32x32x16_bf16(__builtin_bit_cast(bf16x8, pa[kb][s2]), vf, o[d], 0, 0, 0); }
        __syncthreads();
    }
    lrow += __shfl_xor(lrow, 32);
    if (hi == 0) fsc[r32] = 1.f / lrow;
    LDS_WAIT(); asm volatile("" ::: "memory");
#pragma unroll
    for (int r = 0; r < 16; ++r) { const int qr = (r & 3) + 8 * (r >> 2) + 4 * hi; const float rl = fsc[qr];
        bf16* op = CO + (size_t)(256 * rt + 32 * w + qr) * 1024 + h * 256 + dvh * 128 + r32;
#pragma unroll
        for (int d = 0; d < 4; ++d) op[32 * d] = (bf16)f2bf(o[d][r] * rl); }
    __syncthreads();
}
constexpr int X2_KP = 528, X2_VP = 576, X2_K = 0, X2_V = 64 * X2_KP, X2_MX = X2_V + 64 * X2_VP, X2_PEX = X2_MX + 1024, X2_F = X2_PEX + 16384;
__device__ __forceinline__ void xattn_prompt_unit2(const bf16* CQ, const bf16* MKb, const bf16* MVb, bf16* CO, int rt, int h, float mref, LAS unsigned char* lds, int tid_in) {
    int tid = tid_in; asm volatile("" : "+v"(tid));
    const int lane = tid & 63, w = __builtin_amdgcn_readfirstlane(tid >> 6), r32 = lane & 31, hi = lane >> 5, b = rt >> 5, pr = w >> 1, which = w & 1;
    LAS unsigned char* Kt = lds + X2_K; LAS unsigned char* Vt = lds + X2_V; LAS float* fsc = (LAS float*)(lds + X2_F) + w * 32;
    LAS float* mxo = (LAS float*)(lds + X2_MX) + (pr * 2 + which) * 32; LAS float* mxp = (LAS float*)(lds + X2_MX) + (pr * 2 + (which ^ 1)) * 32;
    LAS u32x4* peo = (LAS u32x4*)(lds + X2_PEX) + (pr * 2 + which) * 128; const LAS u32x4* pex0 = (const LAS u32x4*)(lds + X2_PEX) + (pr * 2) * 128;
    bf16x8 qf[16];
    { const bf16* qp = CQ + (size_t)(128 * rt + 32 * pr + r32) * 1024 + h * 256 + 8 * hi;
#pragma unroll
      for (int ds = 0; ds < 16; ++ds) qf[ds] = *(const bf16x8*)(qp + 16 * ds); }
    f32x16 o[4]; o[0] = f32x16{}; o[1] = f32x16{}; o[2] = f32x16{}; o[3] = f32x16{};
    float lrow = 0.f;
#define X2_LBAR() asm volatile("s_waitcnt lgkmcnt(0)\n\ts_barrier" ::: "memory")
    u32x4 kpre[4], vpre[4];
    { const size_t krow0 = (size_t)b * NMEM;
#pragma unroll
      for (int it = 0; it < 4; ++it) { const int idx = tid + 512 * it, key = idx >> 5, c = idx & 31;
          kpre[it] = *(const u32x4*)(MKb + (krow0 + key) * 1024 + h * 256 + c * 8); vpre[it] = *(const u32x4*)(MVb + (krow0 + key) * 1024 + h * 256 + c * 8); } }
#pragma unroll
    for (int kt = 0; kt < 4; ++kt) {
#pragma unroll
        for (int it = 0; it < 4; ++it) { const int idx = tid + 512 * it, key = idx >> 5, c = idx & 31;
            *(LAS u32x4*)(Kt + key * X2_KP + c * 16) = kpre[it]; *(LAS u32x4*)(Vt + key * X2_VP + c * 16) = vpre[it]; }
        if (kt < 3) { const size_t krow0 = (size_t)b * NMEM + 64 * (kt + 1);
#pragma unroll
            for (int it = 0; it < 4; ++it) { const int idx = tid + 512 * it, key = idx >> 5, c = idx & 31;
                kpre[it] = *(const u32x4*)(MKb + (krow0 + key) * 1024 + h * 256 + c * 8); vpre[it] = *(const u32x4*)(MVb + (krow0 + key) * 1024 + h * 256 + c * 8); }
            asm volatile("" ::: "memory"); }
        X2_LBAR();
        f32x16 p = f32x16{};
#pragma unroll
        for (int ds = 0; ds < 16; ++ds) { const bf16x8 k0 = *(const LAS bf16x8*)(Kt + (32 * which + r32) * X2_KP + (16 * ds + 8 * hi) * 2);
            p = __builtin_amdgcn_mfma_f32_32x32x16_bf16(k0, qf[ds], p, 0, 0, 0); }
        float ls = 0.f;
#pragma unroll
        for (int r = 0; r < 16; ++r) { p[r] = __builtin_amdgcn_exp2f(p[r] - mref); ls += p[r]; }
        lrow += ls;
#pragma unroll
        for (int s2 = 0; s2 < 2; ++s2) peo[s2 * 64 + lane] = (u32x4){pg8::cvt_pk_bf16(p[8 * s2], p[8 * s2 + 1]), pg8::cvt_pk_bf16(p[8 * s2 + 2], p[8 * s2 + 3]), pg8::cvt_pk_bf16(p[8 * s2 + 4], p[8 * s2 + 5]), pg8::cvt_pk_bf16(p[8 * s2 + 6], p[8 * s2 + 7])};
        X2_LBAR();
        u32x4 pa[2][2];
#pragma unroll
        for (int s2 = 0; s2 < 2; ++s2) { pa[0][s2] = pex0[s2 * 64 + lane]; pa[1][s2] = pex0[128 + s2 * 64 + lane]; }
        const LAS unsigned char* vb = Vt + (4 * hi + ((lane & 15) >> 2)) * X2_VP + (128 * which + 16 * ((lane >> 4) & 1) + 4 * (lane & 3)) * 2;
#pragma unroll
        for (int d = 0; d < 4; ++d)
#pragma unroll
            for (int kb = 0; kb < 2; ++kb)
#pragma unroll
                for (int s2 = 0; s2 < 2; ++s2) { const LAS unsigned char* pp = vb + (32 * kb + 16 * s2) * X2_VP + d * 64;
                    const v4i16_t lo = __builtin_amdgcn_ds_read_tr16_b64_v4i16((LAS v4i16_t*)pp), hh = __builtin_amdgcn_ds_read_tr16_b64_v4i16((LAS v4i16_t*)(pp + 8 * X2_VP));
                    const bf16x8 vf = (bf16x8){lo[0], lo[1], lo[2], lo[3], hh[0], hh[1], hh[2], hh[3]};
                    o[d] = __builtin_amdgcn_mfma_f32_32x32x16_bf16(__builtin_bit_cast(bf16x8, pa[kb][s2]), vf, o[d], 0, 0, 0);
                    if (kb == 1 && s2 == 1) __builtin_amdgcn_sched_barrier(0); }
        X2_LBAR();
    }
    lrow += __shfl_xor(lrow, 32);
    if (hi == 0) mxo[r32] = lrow;
    __syncthreads();
    if (hi == 0) fsc[r32] = 1.f / (lrow + mxp[r32]);
    LDS_WAIT(); asm volatile("" ::: "memory");
#pragma unroll
    for (int r = 0; r < 16; ++r) { const int qr = (r & 3) + 8 * (r >> 2) + 4 * hi; const float rl = fsc[qr];
        bf16* op = CO + (size_t)(128 * rt + 32 * pr + qr) * 1024 + h * 256 + 128 * which + r32;
#pragma unroll
        for (int d = 0; d < 4; ++d) op[32 * d] = (bf16)f2bf(o[d][r] * rl); }
    __syncthreads();
}
#undef X2_LBAR
template <int NKS, bool ATILED = false, bool FFN = false, bool HALF = false, class EF>
__device__ __forceinline__ void mini_gemm(const bf16* A, const bf16* Wt, int N, int first, int ncu, int bid, LAS unsigned char* lds, int tid, const EF& ef, unsigned* qctr = nullptr, volatile LAS int* qslot = nullptr) {
    const int lane = tid & 63, w = __builtin_amdgcn_readfirstlane(tid >> 6), c16 = lane & 15, kq = lane >> 4;
    static_assert(NKS % 2 == 0, "the waves' K slices are whole 32-wide k-steps");
    constexpr int kw = NKS * 16, K = kw * 8, NS = NKS / 2;
    constexpr int RB = HALF ? 32 : 64, MI = RB / 16; const int ncb = N >> 6, npieces = (512 / RB) * ncb;
    if (bid < first || bid >= first + ncu) return;
    LAS float* lf = (LAS float*)lds;
#pragma unroll 1
    for (int pc = bid - first;; pc += ncu) {
        if (qctr) { __syncthreads(); if (tid == 0) qslot[0] = (int)atomicAdd(qctr, 1u); __syncthreads(); pc = __builtin_amdgcn_readfirstlane(qslot[0]); }
        if (pc >= npieces) break;
        const int rb = pc / ncb, cb = pc - rb * ncb;
        const bf16* a0 = ATILED ? A + (size_t)(MP + RB * rb + c16) * 64 : A + (size_t)(RB * rb + c16) * K + w * kw + 8 * kq;
        const bf16* b0 = Wt + (size_t)((cb >> 2) * 256 + 32 * (cb & 3) + c16) * K + w * kw + 8 * kq;
        f32x4 acc[MI][4];
#pragma unroll
        for (int mi = 0; mi < MI; ++mi)
#pragma unroll
            for (int ni = 0; ni < 4; ++ni) acc[mi][ni] = (f32x4){0.f, 0.f, 0.f, 0.f};
        constexpr int SB = NS < 4 ? NS : 4;
#pragma unroll 1
        for (int s0 = 0; s0 < NS; s0 += SB) {
            bf16x8 Af[SB][MI], Bf[SB][4];
#pragma unroll
            for (int j = 0; j < SB; ++j) if (s0 + j < NS) { const int s = s0 + j;
                if (ATILED) { const int kk = w * kw + 32 * s + 8 * kq; const bf16* at = a0 + (size_t)(kk >> 6) * MTOT * 64 + (kk & 63);
#pragma unroll
                    for (int mi = 0; mi < MI; ++mi) Af[j][mi] = *(const bf16x8*)(at + 16 * mi * 64); }
                else {
#pragma unroll
                    for (int mi = 0; mi < MI; ++mi) Af[j][mi] = *(const bf16x8*)(a0 + (size_t)(16 * mi) * K + 32 * s); }
#pragma unroll
                for (int ni = 0; ni < 4; ++ni) Bf[j][ni] = *(const bf16x8*)(b0 + (size_t)(16 * (ni & 1) + 128 * (ni >> 1)) * K + 32 * s); }
            asm volatile("s_waitcnt vmcnt(0)" ::: "memory");
#pragma unroll
            for (int j = 0; j < SB; ++j) if (s0 + j < NS) {
#pragma unroll
                for (int mi = 0; mi < MI; ++mi)
#pragma unroll
                    for (int ni = 0; ni < 4; ++ni) acc[mi][ni] = __builtin_amdgcn_mfma_f32_16x16x32_bf16(Af[j][mi], Bf[j][ni], acc[mi][ni], 0, 0, 0); }
        }
        LAS float* part = lf + w * 4096;
#pragma unroll
        for (int mi = 0; mi < MI; ++mi)
#pragma unroll
            for (int ni = 0; ni < 4; ++ni)
#pragma unroll
                for (int i = 0; i < 4; ++i) part[(16 * mi + 4 * kq + i) * 64 + 16 * ni + c16] = acc[mi][ni][i];
        __syncthreads();
        const int row = tid >> 3, c8 = (tid & 7) * 8; float v[8];
        if (!HALF || tid < 256) {
#pragma unroll
        for (int i = 0; i < 8; ++i) v[i] = 0.f;
#pragma unroll
        for (int w2 = 0; w2 < 8; ++w2) { const f32x4 x = *(const LAS f32x4*)(lf + w2 * 4096 + row * 64 + c8), y = *(const LAS f32x4*)(lf + w2 * 4096 + row * 64 + c8 + 4);
            v[0] += x[0]; v[1] += x[1]; v[2] += x[2]; v[3] += x[3]; v[4] += y[0]; v[5] += y[1]; v[6] += y[2]; v[7] += y[3]; }
        }
        if constexpr (FFN) ef.ffn(lf, 64 * rb + row, row, cb, c8, v);
        else if (!HALF || tid < 256) ef(RB * rb + row, 64 * cb + c8, v, lane);
        __syncthreads();
    }
}
namespace mef {
__device__ __forceinline__ float ss64(const float (&v)[8]) { float s = 0.f;
#pragma unroll
    for (int i = 0; i < 8; ++i) s += v[i] * v[i];
    return oct_allsum(s); }
__device__ __forceinline__ u32x4 pk8(const float (&v)[8]) { u32x4 o; o.x = pk2(v[0], v[1]); o.y = pk2(v[2], v[3]); o.z = pk2(v[4], v[5]); o.w = pk2(v[6], v[7]); return o; }
__device__ __forceinline__ void st8(float* p, const float (&v)[8]) { *(f32x4*)p = (f32x4){v[0], v[1], v[2], v[3]}; *(f32x4*)(p + 4) = (f32x4){v[4], v[5], v[6], v[7]}; }
__device__ __forceinline__ void ld8(const float* p, float (&g)[8]) { const f32x4 a = *(const f32x4*)p, b = *(const f32x4*)(p + 4); g[0] = a[0]; g[1] = a[1]; g[2] = a[2]; g[3] = a[3]; g[4] = b[0]; g[5] = b[1]; g[6] = b[2]; g[7] = b[3]; }
__device__ __forceinline__ void ld8bf(const bf16* p, float (&g)[8]) { const u32x4 w = *(const u32x4*)p; g[0] = bflo(w.x); g[1] = bfhi(w.x); g[2] = bflo(w.y); g[3] = bfhi(w.y); g[4] = bflo(w.z); g[5] = bfhi(w.z); g[6] = bflo(w.w); g[7] = bfhi(w.w); }
struct In { bf16 *UG, *Qb, *Kb, *Vb; float* out; const float *qg, *kg;
    __device__ __forceinline__ void operator()(int r, int c, float (&v)[8], int) const { const size_t gr = (size_t)MP + r;
        if (c < 512) { *(u32x4*)(UG + ((size_t)(c >> 4) * MTOT + gr) * 16 + (c & 15)) = pk8(v); }
        else if (c < 1536) { const bool isq = c < 1024; const float rinv = 1.f / sqrtf(ss64(v) * (1.f / 64.f) + EPS) * (isq ? C2 : 1.f); float g[8]; ld8((isq ? qg : kg) + (c & 63), g);
#pragma unroll
            for (int i = 0; i < 8; ++i) v[i] *= rinv * g[i];
            if (isq) *(u32x4*)(Qb + gr * 512 + (c - 512)) = pk8(v);
            else { *(u32x4*)(Kb + gr * 512 + (c - 1024)) = pk8(v); st8(out + O_KS + (size_t)r * 512 + (c - 1024), v); } }
        else { *(u32x4*)(Vb + gr * 512 + (c - 1536)) = pk8(v); st8(out + O_VS + (size_t)r * 512 + (c - 1536), v); } } };
struct Glu { const bf16* Gb; bf16* MIX;
    __device__ __forceinline__ void operator()(int r, int c, float (&v)[8], int) const { const size_t gr = (size_t)MP + r; float g[8]; ld8bf(Gb + gr * 512 + c, g);
#pragma unroll
        for (int i = 0; i < 8; ++i) v[i] = g[i] * ep::sigm(v[i]);
        *(u32x4*)(MIX + gr * 1024 + c) = pk8(v); } };
template <bool RES_BF16> struct Res { const void* res; bf16* XB; float* SS;
    __device__ __forceinline__ void operator()(int r, int c, float (&v)[8], int lane) const { const size_t gr = (size_t)MP + r; float x[8];
        if (RES_BF16) ld8bf((const bf16*)res + (size_t)r * DMODEL + c, x); else ld8((const float*)res + (size_t)r * DMODEL + c, x);
#pragma unroll
        for (int i = 0; i < 8; ++i) v[i] += x[i];
        const float s = ss64(v); if ((lane & 7) == 0) SS[gr * 16 + (c >> 6)] = s;
        *(u32x4*)(XB + gr * DMODEL + c) = pk8(v); } };
struct Cq { const float* SS; bf16* CQ; float* SSQ; const float* gq;
    __device__ __forceinline__ void operator()(int r, int c, float (&v)[8], int lane) const { const size_t gr = (size_t)MP + r; const float rs = ep::row_rs(SS, (int)gr); float g[8]; ld8(gq + (c & 255), g);
#pragma unroll
        for (int i = 0; i < 8; ++i) v[i] *= rs;
        const float s = ss64(v); if ((lane & 7) == 0) SSQ[(size_t)r * 16 + (c >> 6)] = s;
#pragma unroll
        for (int i = 0; i < 8; ++i) v[i] *= g[i] * CA2;
        *(u32x4*)(CQ + gr * DMODEL + c) = pk8(v); } };
struct Ffn { const float* SS; bf16* H; float* out; const float* cw_; const float* cb_; const float* sconv;
    __device__ __forceinline__ void ffn(LAS float* T, int r, int row, int cb, int c8, float (&v)[8]) const {
        const size_t gr = (size_t)MP + r; const float rs = ep::row_rs(SS, (int)gr);
        __syncthreads();
        *(LAS f32x4*)(T + row * 64 + c8) = (f32x4){v[0] * rs, v[1] * rs, v[2] * rs, v[3] * rs}; *(LAS f32x4*)(T + row * 64 + c8 + 4) = (f32x4){v[4] * rs, v[5] * rs, v[6] * rs, v[7] * rs};
        __syncthreads();
        if (c8 < 32) { const int ch = 128 * (cb >> 2) + 32 * (cb & 3) + c8, t = r & 3; const float* prev = sconv + (size_t)(r >> 2) * 2 * FF; float h0[8], h1[8], h2[8], hv[8], w0[8], w1[8], w2[8], bb[8];
#pragma unroll
            for (int i = 0; i < 8; ++i) { h2[i] = T[row * 64 + c8 + i]; hv[i] = T[row * 64 + 32 + c8 + i]; }
            if (t >= 1) {
#pragma unroll
                for (int i = 0; i < 8; ++i) h1[i] = T[(row - 1) * 64 + c8 + i]; } else ld8(prev + FF + ch, h1);
            if (t >= 2) {
#pragma unroll
                for (int i = 0; i < 8; ++i) h0[i] = T[(row - 2) * 64 + c8 + i]; } else ld8(prev + (size_t)t * FF + ch, h0);
            ld8(cw_ + ch, w0); ld8(cw_ + FF + ch, w1); ld8(cw_ + 2 * FF + ch, w2); ld8(cb_ + ch, bb);
            if (t >= 2) st8(out + O_CS + (size_t)((r >> 2) * 2 + (t - 2)) * FF + ch, h2);
            float o[8];
#pragma unroll
            for (int i = 0; i < 8; ++i) { const float cv = bb[i] + w0[i] * h0[i] + w1[i] * h1[i] + w2[i] * h2[i]; o[i] = cv * ep::sigm(cv) * hv[i]; }
            *(u32x4*)(H + hidx(gr, ch)) = pk8(o); }
    } };
struct Out { const bf16* X2; float* out;
    __device__ __forceinline__ void operator()(int r, int c, float (&v)[8], int) const { float x[8]; ld8bf(X2 + ((size_t)MP + r) * DMODEL + c, x);
#pragma unroll
        for (int i = 0; i < 8; ++i) v[i] += x[i];
        st8(out + O_YS + (size_t)r * DMODEL + c, v); } };
}
#ifndef MK_ONE_LAUNCH
#define MK_ONE_LAUNCH 1
#endif
#ifndef MK_DBL
#define MK_DBL -1
#endif
#define REP(k) for (int rep_ = 0; rep_ < ((MK_DBL == (k)) ? 2 : 1); ++rep_)
#ifndef MK_PH_END
#define MK_PH_END 10
#endif
constexpr int N_PHASES = MK_PH_END;
struct Args { const void* in[N_IN]; float* out; unsigned char* ws; int ph_lo, ph_hi; };
__global__ void __launch_bounds__(512, 2) mk_fwd(Args a) {
    extern __shared__ __attribute__((aligned(16))) unsigned char lds_raw[];
    LAS unsigned char* lds = (LAS unsigned char*)lds_raw;
    const int tid = threadIdx.x, lane = tid & 63, wave = __builtin_amdgcn_readfirstlane(tid >> 6);
    const int G = gridDim.x, bid = blockIdx.x;
    unsigned char* ws = a.ws; float* out = a.out;
    volatile LAS unsigned* MISC = (volatile LAS unsigned*)(lds + MISC_OFF);
    if (tid < 16) MISC[tid] = 0u;
    __syncthreads();
    XcdBarrier bar; bar.bar = (unsigned*)(ws + WS_CTL) + CW_BAR; bar.x = 0; bar.st = nullptr;
    if (MK_ONE_LAUNCH) bar = xcd_barrier_post((unsigned*)(ws + WS_CTL) + CW_BAR, MISC + 8);
#define GRID_BAR() do { if (MK_ONE_LAUNCH) { xcd_barrier(bar); if (MK_DBL == 99) xcd_barrier(bar); } } while (0)
    const int lo = a.ph_lo, hi = a.ph_hi;
#define IN(k) (lo <= (k) && (k) < hi)
#define BOTH(k) (IN(k) && IN((k) + 1))
#define INF(i) ((const float*)a.in[i])
    const int gw = bid * 8 + wave, NGW = G * 8;

    if (IN(0)) REP(0) {
        __syncthreads();
        for (int it = bid; it < NG * 8; it += G)
            ssm_tables(INF(I_ARE), INF(I_AIM), INF(I_BRE), INF(I_BIM), INF(I_CRE), INF(I_CIM), INF(I_D), INF(I_LDT),
                       (bf16*)(ws + WS_TQ), (bf16*)(ws + WS_PM), (float*)(ws + WS_SSMF), it >> 3, it & 7, (LAS float*)lds, tid);
        {
            LAS float* scr = (LAS float*)(lds + wave * 16384);
            constexpr int I_1 = (1024 / 64) * (2048 / 32), I_2 = (1024 / 64) * (1024 / 32), I_3 = (512 / 64) * (512 / 32), I_4 = (1024 / 64) * (FF / 32), I_5 = (FF / 64) * (1024 / 32);
            constexpr int NITEMS = I_1 + 2 * I_2 + I_3 + 3 * I_2 + 2 * I_4 + I_5, NEARLY = I_1 + 2 * I_2 + I_3;
            const int nitems = (G == 256) ? NEARLY : NITEMS;
            for (int it = gw; it < nitems; it += NGW) {
                int r = it;
                if (r < I_1) { transpose_item(INF(I_WIN), 1024, 2048, (bf16*)(ws + WS_WIN), 0, scr, r, lane); continue; } r -= I_1;
                if (r < I_2) { transpose_item(INF(I_WK), 1024, 1024, (bf16*)(ws + WS_WKV), 0, scr, r, lane); continue; } r -= I_2;
                if (r < I_2) { transpose_item(INF(I_WV), 1024, 1024, (bf16*)(ws + WS_WKV), 1024, scr, r, lane); continue; } r -= I_2;
                if (r < I_3) { transpose_item(INF(I_GLU), 512, 512, (bf16*)(ws + WS_GLU), 0, scr, r, lane); continue; } r -= I_3;
                if (r < I_2) { transpose_item(INF(I_WOUT), 1024, 1024, (bf16*)(ws + WS_WOUT), 0, scr, r, lane); continue; } r -= I_2;
                if (r < I_2) { transpose_item(INF(I_WQ), 1024, 1024, (bf16*)(ws + WS_WQ), 0, scr, r, lane, INF(I_LN2)); continue; } r -= I_2;
                if (r < I_2) { transpose_item(INF(I_WO), 1024, 1024, (bf16*)(ws + WS_WO), 0, scr, r, lane); continue; } r -= I_2;
                if (r < I_4) { transpose_item(INF(I_WG), 1024, FF, (bf16*)(ws + WS_WG), 0, scr, r, lane, INF(I_LN3), 1); continue; } r -= I_4;
                if (r < I_4) { transpose_item(INF(I_WVV), 1024, FF, (bf16*)(ws + WS_WG), 0, scr, r, lane, INF(I_LN3), 2); continue; } r -= I_4;
                transpose_item(INF(I_WD), FF, 1024, (bf16*)(ws + WS_WD), 0, scr, r, lane);
            }
        }
        for (int m = gw; m < MTOT + MMEM; m += NGW) {
            if (m < MP) rms_row_to_bf16(INF(I_XP) + (size_t)m * DMODEL, INF(I_LN1), (bf16*)(ws + WS_XN1) + (size_t)m * DMODEL, lane);
            else if (m < MTOT) rms_row_to_bf16(INF(I_XS) + (size_t)(m - MP) * DMODEL, INF(I_LN1), (bf16*)(ws + WS_XN1) + (size_t)m * DMODEL, lane);
            else rms_row_to_bf16(INF(I_MEM) + (size_t)(m - MTOT) * DMODEL, INF(I_MEMG), (bf16*)(ws + WS_MN) + (size_t)(m - MTOT) * DMODEL, lane);
        }
        if (BOTH(0) && rep_ == ((MK_DBL == 0) ? 1 : 0)) GRID_BAR();
    }
#define LATE_TRANSPOSE(NIT, CALL) do { if (G == 256 && bid >= 128) { LAS float* scr = (LAS float*)(lds + wave * 16384); \
        for (int r = (bid - 128) * 8 + wave; r < (NIT); r += 1024) { CALL; } } } while (0)
    if (IN(1)) {
        { pg8::Gemm g{(const bf16*)(ws + WS_XN1), (const bf16*)(ws + WS_WIN), MP, INCOLS, DMODEL}; pg8::StaticOrder S; S.init(MP, INCOLS, G, bid);
          ep::EpiIn E{(bf16*)(ws + WS_UG), (bf16*)(ws + WS_QB), (bf16*)(ws + WS_KB), (bf16*)(ws + WS_VB), out, INF(I_QG), INF(I_KG)};
          pg8::gemm_phase<ep::EpiIn, pg8::StaticOrder, true, true>(lds, g, S, E);
#if MK_DBL == 1
          __syncthreads(); pg8::gemm_phase<ep::EpiIn, pg8::StaticOrder, true, true>(lds, g, S, E);
#endif
          }
        __syncthreads();
        mini_gemm<8>((const bf16*)(ws + WS_XN1) + (size_t)MP * DMODEL, (const bf16*)(ws + WS_WIN), INCOLS, 0, G, bid, lds, tid,
                  mef::In{(bf16*)(ws + WS_UG), (bf16*)(ws + WS_QB), (bf16*)(ws + WS_KB), (bf16*)(ws + WS_VB), out, INF(I_QG), INF(I_KG)});
        if (BOTH(1)) GRID_BAR();
    }
    if (IN(2)) {
        __syncthreads();
        { pg8::Gemm g{(const bf16*)(ws + WS_MN), (const bf16*)(ws + WS_WKV), MMEM, 2048, DMODEL}; pg8::StaticOrder S; S.init(MMEM, 2048, G, (bid + G - G / 2) % G);
          ep::EpiMemKV E{out, (bf16*)(ws + WS_MKB), (bf16*)(ws + WS_MVB), INF(I_CAKG), (LAS float*)(lds + EPI_SCR_OFF)};
          pg8::gemm_phase<ep::EpiMemKV, pg8::StaticOrder, true, true>(lds, g, S, E); }
        __syncthreads();
        __syncthreads();
        for (int it = bid; it < NBATCH * NG; it += G)
            ssm_prompt_item((const bf16*)(ws + WS_UG), (const bf16*)(ws + WS_TQ), (const bf16*)(ws + WS_PM), (const float*)(ws + WS_SSMF), (bf16*)(ws + WS_G), out, it / NG, it % NG, lds, tid);
#if MK_DBL == 20
        for (int it = bid; it < NBATCH * NG; it += G)
            ssm_prompt_item((const bf16*)(ws + WS_UG), (const bf16*)(ws + WS_TQ), (const bf16*)(ws + WS_PM), (const float*)(ws + WS_SSMF), (bf16*)(ws + WS_G), out, it / NG, it % NG, lds, tid);
#endif
        { LAS float* hs = (LAS float*)(lds + wave * 11264); LAS float* Cl = hs + 512; int gcur = -1;
          for (int it = gw; it < NDEC * NG; it += NGW) { const int s_ = it / NG, g_ = it % NG;
              if (g_ != gcur) { gcur = g_;
#pragma unroll
                  for (int q = 0; q < 4; ++q) { const int i4 = lane + 64 * q; *(LAS f32x4*)(Cl + (i4 >> 4) * 68 + 4 * (i4 & 15)) = *(const f32x4*)(INF(I_CRE) + g_ * 1024 + 4 * i4);
                      *(LAS f32x4*)(Cl + 16 * 68 + (i4 >> 4) * 68 + 4 * (i4 & 15)) = *(const f32x4*)(INF(I_CIM) + g_ * 1024 + 4 * i4); }
                  LDS_WAIT(); asm volatile("" ::: "memory"); }
              ssm_sample_item((const bf16*)(ws + WS_UG), (const float*)(ws + WS_SSMF), INF(I_CRE), INF(I_CIM), INF(I_D), INF(I_SRE), INF(I_SIM), (bf16*)(ws + WS_G), out, s_, g_, hs, Cl, lane); } }
        const float smax2 = __builtin_bit_cast(float, __builtin_amdgcn_readfirstlane(__builtin_bit_cast(int, 8.f * wave_max(fabsf(INF(I_QG)[lane])) * wave_max(fabsf(INF(I_KG)[lane])) * LOG2E)));
        __syncthreads();
#pragma unroll 1
        for (int c0_ = bid; c0_ < 256; c0_ += G) {
            const int c = (G == 256) ? (c0_ & 7) * 32 + (c0_ >> 3) : c0_;
            const int grp = c >> 4, j = c & 15, b = grp >> 2, map = (grp >> 1) & 1, vh = grp & 1;
            bf16x8 qrx[4];
#pragma unroll
            for (int d = 0; d < 4; ++d) qrx[d] = bf16x8{};
#pragma unroll 1
            for (int i = 0; i < 4; ++i) { const int h = 3 - i, qb = (i & 1) ? 15 - j : j;
                const float a2 = __builtin_bit_cast(float, __builtin_amdgcn_readfirstlane(__builtin_bit_cast(int, exp2f(-2.f * (float)(h + 1)) * LOG2E)));
                const int W = (int)fminf((2.f * smax2 + 36.f) / a2 + 1.f, 1.0e6f); int t0 = (qb * 256 - W) >> 6; t0 = (t0 < 0 ? 0 : t0) & ~1;
                t0 = __builtin_amdgcn_readfirstlane(t0);
                const size_t qoff = (size_t)(h * 128 + map * 64) * 2, voff = (size_t)(h * 128 + vh * 64) * 2;
                const int hn = i < 3 ? 2 - i : 0, qbn = (i & 1) ? j : 15 - j;
                const float a2n = exp2f(-2.f * (float)(hn + 1)) * LOG2E; const int Wn = (int)fminf((2.f * smax2 + 36.f) / a2n + 1.f, 1.0e6f); int t0n = (qbn * 256 - Wn) >> 6; t0n = (t0n < 0 ? 0 : t0n) & ~1;
                t0n = __builtin_amdgcn_readfirstlane(t0n);
                const size_t qoffn = (size_t)(hn * 128 + map * 64) * 2;
#ifndef NO_ATTN
                attn_body::attn_unit<60>(b, qb, (const attn_body::bf16*)(ws + WS_QB + qoff), (const attn_body::bf16*)(ws + WS_KB + qoff), (const attn_body::bf16*)(ws + WS_VB + voff),
                                        (attn_body::bf16*)(ws + (map ? WS_O1 : WS_O0) + voff), (char*)lds_raw, a2, t0, smax2 * 1.01f + 0.25f,
                                        qrx, i > 0, i < 3, qbn, (const attn_body::bf16*)(ws + WS_QB + qoffn), (const attn_body::bf16*)(ws + WS_KB + qoffn), t0n);
#endif
            }
        }
#if MK_DBL == 21
#pragma unroll 1
        for (int c0_ = bid; c0_ < 256; c0_ += G) {
            const int c = (G == 256) ? (c0_ & 7) * 32 + (c0_ >> 3) : c0_;
            const int grp = c >> 4, j = c & 15, b = grp >> 2, map = (grp >> 1) & 1, vh = grp & 1;
            bf16x8 qrx[4];
#pragma unroll
            for (int d = 0; d < 4; ++d) qrx[d] = bf16x8{};
#pragma unroll 1
            for (int i = 0; i < 4; ++i) { const int h = 3 - i, qb = (i & 1) ? 15 - j : j;
                const float a2 = __builtin_bit_cast(float, __builtin_amdgcn_readfirstlane(__builtin_bit_cast(int, exp2f(-2.f * (float)(h + 1)) * LOG2E)));
                const int W = (int)fminf((2.f * smax2 + 36.f) / a2 + 1.f, 1.0e6f); int t0 = (qb * 256 - W) >> 6; t0 = (t0 < 0 ? 0 : t0) & ~1;
                t0 = __builtin_amdgcn_readfirstlane(t0);
                const size_t qoff = (size_t)(h * 128 + map * 64) * 2, voff = (size_t)(h * 128 + vh * 64) * 2;
                const int hn = i < 3 ? 2 - i : 0, qbn = (i & 1) ? j : 15 - j;
                const float a2n = exp2f(-2.f * (float)(hn + 1)) * LOG2E; const int Wn = (int)fminf((2.f * smax2 + 36.f) / a2n + 1.f, 1.0e6f); int t0n = (qbn * 256 - Wn) >> 6; t0n = (t0n < 0 ? 0 : t0n) & ~1;
                t0n = __builtin_amdgcn_readfirstlane(t0n);
                const size_t qoffn = (size_t)(hn * 128 + map * 64) * 2;
#ifndef NO_ATTN
                attn_body::attn_unit<60>(b, qb, (const attn_body::bf16*)(ws + WS_QB + qoff), (const attn_body::bf16*)(ws + WS_KB + qoff), (const attn_body::bf16*)(ws + WS_VB + voff),
                                        (attn_body::bf16*)(ws + (map ? WS_O1 : WS_O0) + voff), (char*)lds_raw, a2, t0, smax2 * 1.01f + 0.25f,
                                        qrx, i > 0, i < 3, qbn, (const attn_body::bf16*)(ws + WS_QB + qoffn), (const attn_body::bf16*)(ws + WS_KB + qoffn), t0n);
#endif
            }
        }
#endif
        __syncthreads();
        { const float lam = __builtin_bit_cast(float, __builtin_amdgcn_readfirstlane(__builtin_bit_cast(int, lam_value(INF(I_LQ1), INF(I_LK1), INF(I_LQ2), INF(I_LK2), lane))));
          unsigned* qctr = (unsigned*)(ws + WS_CTL) + CW_QUEUE; volatile LAS int* qslot = (volatile LAS int*)(MISC);
#pragma unroll 1
          for (;;) {
              __syncthreads();
              if (tid == 0) qslot[0] = (int)atomicAdd(qctr, 1u);
              __syncthreads();
              const int u_ = __builtin_amdgcn_readfirstlane(qslot[0]);
              if (u_ >= NDEC * NH * ((MK_DBL == 22) ? 2 : 1)) break;
              const int u = u_ & (NDEC * NH - 1);
              const int h = 3 - (u >> 7), s = u & 127;
              const float a2 = exp2f(-2.f * (float)(h + 1)) * LOG2E; const int W = (int)fminf((2.f * smax2 + 36.f) / a2 + 1.f, 1.0e6f);
              int c0 = (PAST - W) >> 6; c0 = __builtin_amdgcn_readfirstlane(c0 < 0 ? 0 : c0);
#ifndef NO_SATTN
              sattn_unit((const bf16*)(ws + WS_QB), (const bf16*)(ws + WS_KB), (const bf16*)(ws + WS_VB), INF(I_CK), INF(I_CV), (const int*)a.in[I_PT], (bf16*)(ws + WS_MIX), INF(I_SUBLN), lam, s, h, c0, lds, tid);
#endif
          } }
        if (BOTH(2)) GRID_BAR();
    }
    if (IN(3)) {
        if (G == 256 && bid >= 128 && (bid < 160 || bid >= 224)) {
            __syncthreads(); LAS float* scr = (LAS float*)(lds + wave * 16384); const int wv = ((bid < 160 ? bid - 128 : bid - 192)) * 8 + wave;
            for (int r = wv; r < 2 * (1024 / 64) * (1024 / 32); r += 512) {
                if (r < 512) transpose_item(INF(I_WOUT), 1024, 1024, (bf16*)(ws + WS_WOUT), 0, scr, r, lane);
                else transpose_item(INF(I_WQ), 1024, 1024, (bf16*)(ws + WS_WQ), 0, scr, r - 512, lane, INF(I_LN2)); }
            __syncthreads(); }
        { const float lam = lam_value(INF(I_LQ1), INF(I_LK1), INF(I_LQ2), INF(I_LK2), lane);
          int m0, m1, cw0, ncw;
          if (G == 256) { const bool glu = bid < 128; m0 = glu ? 0 : 5120; m1 = glu ? 5120 : MP; cw0 = (glu ? bid : bid - 128) * 8 + wave; ncw = 1024; } else { m0 = 0; m1 = MP; cw0 = gw; ncw = NGW; }
          { int m = m0 + cw0;
              for (; m + 3 * ncw < m1; m += 4 * ncw) combine_rows<4>((const bf16*)(ws + WS_O0), (const bf16*)(ws + WS_O1), (bf16*)(ws + WS_MIX), INF(I_SUBLN), lam, m, ncw, lane);
              for (; m < m1; m += ncw) combine_rows<1>((const bf16*)(ws + WS_O0), (const bf16*)(ws + WS_O1), (bf16*)(ws + WS_MIX), INF(I_SUBLN), lam, m, ncw, lane); } }
        { pg8::Gemm g{(const bf16*)(ws + WS_G), (const bf16*)(ws + WS_GLU), MP, 512, 512}; pg8::StaticOrder S; S.init(MP, 512, G, bid);
          ep::EpiGlu E{(const bf16*)(ws + WS_G), (bf16*)(ws + WS_MIX)};
          pg8::gemm_phase<ep::EpiGlu, pg8::StaticOrder, true, true>(lds, g, S, E);
#if MK_DBL == 3
          __syncthreads(); pg8::gemm_phase<ep::EpiGlu, pg8::StaticOrder, true, true>(lds, g, S, E);
#endif
          }
        __syncthreads();
        mini_gemm<4>((const bf16*)(ws + WS_G) + (size_t)MP * 512, (const bf16*)(ws + WS_GLU), 512, (G >= 256 ? 160 : 0), (G >= 256 ? 64 : G), bid, lds, tid, mef::Glu{(const bf16*)(ws + WS_G), (bf16*)(ws + WS_MIX)});
        if (BOTH(3)) GRID_BAR();
    }
    if (IN(4)) {
        __syncthreads();
        LATE_TRANSPOSE((FF / 64) * (1024 / 32), transpose_item(INF(I_WD), FF, 1024, (bf16*)(ws + WS_WD), 0, scr, r, lane));
        mini_gemm<8>((const bf16*)(ws + WS_MIX) + (size_t)MP * DMODEL, (const bf16*)(ws + WS_WOUT), DMODEL, 0, G, bid, lds, tid,
                  mef::Res<false>{INF(I_XS), (bf16*)(ws + WS_XB1), (float*)(ws + WS_SS1)});
        __syncthreads();
        pg8::Gemm g{(const bf16*)(ws + WS_MIX), (const bf16*)(ws + WS_WOUT), MP, DMODEL, DMODEL}; pg8::StaticOrder S; S.init(MP, DMODEL, G, bid);
        ep::EpiRes<false> E{INF(I_XP), (bf16*)(ws + WS_XB1), (float*)(ws + WS_SS1)};
        pg8::gemm_phase<ep::EpiRes<false>, pg8::StaticOrder, true, true>(lds, g, S, E);
#if MK_DBL == 4
        __syncthreads(); pg8::gemm_phase<ep::EpiRes<false>, pg8::StaticOrder, true, true>(lds, g, S, E);
#endif
        if (BOTH(4)) GRID_BAR();
    }
    if (IN(5)) {
        __syncthreads();
        LATE_TRANSPOSE((1024 / 64) * (1024 / 32), transpose_item(INF(I_WO), 1024, 1024, (bf16*)(ws + WS_WO), 0, scr, r, lane));
        LATE_TRANSPOSE((1024 / 64) * (FF / 32), transpose_item(INF(I_WG), 1024, FF, (bf16*)(ws + WS_WG), 0, scr, r, lane, INF(I_LN3), 1));
        mini_gemm<8>((const bf16*)(ws + WS_XB1) + (size_t)MP * DMODEL, (const bf16*)(ws + WS_WQ), DMODEL, 0, G, bid, lds, tid,
                  mef::Cq{(const float*)(ws + WS_SS1), (bf16*)(ws + WS_CQ), (float*)(ws + WS_SSQ), INF(I_CAQG)});
        __syncthreads();
        pg8::Gemm g{(const bf16*)(ws + WS_XB1), (const bf16*)(ws + WS_WQ), MP, DMODEL, DMODEL}; pg8::StaticOrder S; S.init(MP, DMODEL, G, bid);
        ep::EpiCq E{(const float*)(ws + WS_SS1), (bf16*)(ws + WS_CQ), INF(I_CAQG), (LAS float*)(lds + EPI_SCR_OFF), (LAS float*)(lds + EPI_RS_OFF)};
        pg8::gemm_phase<ep::EpiCq, pg8::StaticOrder, true, true>(lds, g, S, E);
#if MK_DBL == 5
        __syncthreads(); pg8::gemm_phase<ep::EpiCq, pg8::StaticOrder, true, true>(lds, g, S, E);
#endif
        if (BOTH(5)) GRID_BAR();
    }
    if (IN(6)) {
        __syncthreads();
        float xmref; { float gq = 0.f, gk = 0.f;
#pragma unroll
            for (int i = 0; i < 4; ++i) { gq = fmaxf(gq, fabsf(INF(I_CAQG)[lane + 64 * i])); gk = fmaxf(gk, fabsf(INF(I_CAKG)[lane + 64 * i])); }
            xmref = __builtin_bit_cast(float, __builtin_amdgcn_readfirstlane(__builtin_bit_cast(int, 16.f * wave_max(gq) * wave_max(gk) * LOG2E * 1.01f + 0.25f))); }
#pragma unroll 1
        for (int k = 0; k < 2 * ((512 + G - 1) / G); ++k) { const int it = k >> 1, u = bid + it * G; if (u >= 512) break;
            if (((k ^ (bid >> 3)) & 1) == 0) xattn_prompt_unit2((const bf16*)(ws + WS_CQ), (const bf16*)(ws + WS_MKB), (const bf16*)(ws + WS_MVB), (bf16*)(ws + WS_CO), u >> 2, u & 3, xmref, lds, tid);
            else xattn_sample_unit((const bf16*)(ws + WS_CQ), (const float*)(ws + WS_SSQ), INF(I_CMK), INF(I_CMV), (bf16*)(ws + WS_CO), u >> 2, u & 3, lds, tid);
        }
#if MK_DBL == 12
#pragma unroll 1
        for (int u = bid; u < 512; u += G) xattn_sample_unit((const bf16*)(ws + WS_CQ), (const float*)(ws + WS_SSQ), INF(I_CMK), INF(I_CMV), (bf16*)(ws + WS_CO), u >> 2, u & 3, lds, tid);
#endif
#if MK_DBL == 13
#pragma unroll 1
        for (int u = bid; u < 512; u += G) xattn_prompt_unit2((const bf16*)(ws + WS_CQ), (const bf16*)(ws + WS_MKB), (const bf16*)(ws + WS_MVB), (bf16*)(ws + WS_CO), u >> 2, u & 3, xmref, lds, tid);
#endif
#if MK_DBL == 6
#pragma unroll 1
        for (int k = 0; k < 2 * ((512 + G - 1) / G); ++k) { const int it = k >> 1, u = bid + it * G; if (u >= 512) break;
            if (((k ^ (bid >> 3)) & 1) == 0) xattn_prompt_unit2((const bf16*)(ws + WS_CQ), (const bf16*)(ws + WS_MKB), (const bf16*)(ws + WS_MVB), (bf16*)(ws + WS_CO), u >> 2, u & 3, xmref, lds, tid);
            else xattn_sample_unit((const bf16*)(ws + WS_CQ), (const float*)(ws + WS_SSQ), INF(I_CMK), INF(I_CMV), (bf16*)(ws + WS_CO), u >> 2, u & 3, lds, tid);
        }
#endif
        if (BOTH(6)) GRID_BAR();
    }
    if (IN(7)) {
        __syncthreads();
        LATE_TRANSPOSE((1024 / 64) * (FF / 32), transpose_item(INF(I_WVV), 1024, FF, (bf16*)(ws + WS_WG), 0, scr, r, lane, INF(I_LN3), 2));
        mini_gemm<8>((const bf16*)(ws + WS_CO) + (size_t)MP * DMODEL, (const bf16*)(ws + WS_WO), DMODEL, 0, G, bid, lds, tid,
                  mef::Res<true>{(const bf16*)(ws + WS_XB1) + (size_t)MP * DMODEL, (bf16*)(ws + WS_XB2), (float*)(ws + WS_SS2)});
        __syncthreads();
        pg8::Gemm g{(const bf16*)(ws + WS_CO), (const bf16*)(ws + WS_WO), MP, DMODEL, DMODEL}; pg8::StaticOrder S; S.init(MP, DMODEL, G, bid);
        ep::EpiRes<true> E{(const bf16*)(ws + WS_XB1), (bf16*)(ws + WS_XB2), (float*)(ws + WS_SS2)};
        pg8::gemm_phase<ep::EpiRes<true>, pg8::StaticOrder, true, true>(lds, g, S, E);
#if MK_DBL == 7
        __syncthreads(); pg8::gemm_phase<ep::EpiRes<true>, pg8::StaticOrder, true, true>(lds, g, S, E);
#endif
        if (BOTH(7)) GRID_BAR();
    }
    if (IN(8)) {
        __syncthreads();
#pragma unroll 1
        for (int run = bid; run < ep::FFN_RUNS; run += G) {
            ep::RunOrder S; S.init(run);
            ep::ffn_carry_init((const bf16*)(ws + WS_XB2), (const bf16*)(ws + WS_WG), (const float*)(ws + WS_SS2), S.pm0, S.pn, (LAS float*)(lds + EPI_HALO_OFF), tid);
            pg8::Gemm g{(const bf16*)(ws + WS_XB2), (const bf16*)(ws + WS_WG), MP, 2 * FF, DMODEL};
            ep::EpiFfn E{(const float*)(ws + WS_SS2), (bf16*)(ws + WS_H), out, INF(I_CONVW), INF(I_CONVB), (LAS float*)(lds + EPI_RS_OFF), (LAS float*)(lds + EPI_HALO_OFF)};
            pg8::gemm_phase<ep::EpiFfn, ep::RunOrder, true, true>(lds, g, S, E);
            __syncthreads();
        }
#if MK_DBL == 8
#pragma unroll 1
        for (int run = bid; run < ep::FFN_RUNS; run += G) {
            ep::RunOrder S; S.init(run);
            ep::ffn_carry_init((const bf16*)(ws + WS_XB2), (const bf16*)(ws + WS_WG), (const float*)(ws + WS_SS2), S.pm0, S.pn, (LAS float*)(lds + EPI_HALO_OFF), tid);
            pg8::Gemm g{(const bf16*)(ws + WS_XB2), (const bf16*)(ws + WS_WG), MP, 2 * FF, DMODEL};
            ep::EpiFfn E{(const float*)(ws + WS_SS2), (bf16*)(ws + WS_H), out, INF(I_CONVW), INF(I_CONVB), (LAS float*)(lds + EPI_RS_OFF), (LAS float*)(lds + EPI_HALO_OFF)};
            pg8::gemm_phase<ep::EpiFfn, ep::RunOrder, true, true>(lds, g, S, E);
            __syncthreads();
        }
#endif
        mini_gemm<8, false, true>((const bf16*)(ws + WS_XB2) + (size_t)MP * DMODEL, (const bf16*)(ws + WS_WG), 2 * FF, 0, G, bid, lds, tid,
                  mef::Ffn{(const float*)(ws + WS_SS2), (bf16*)(ws + WS_H), out, INF(I_CONVW), INF(I_CONVB), INF(I_SCONV)},
                  (unsigned*)(ws + WS_CTL) + CW_QUEUE2, (volatile LAS int*)(MISC));
        if (BOTH(8)) GRID_BAR();
    }
    if (IN(9)) {
        __syncthreads();
        mini_gemm<22, true, false, true>((const bf16*)(ws + WS_H), (const bf16*)(ws + WS_WD), DMODEL, 0, G, bid, lds, tid, mef::Out{(const bf16*)(ws + WS_XB2), out});
#if MK_DBL == 11
        __syncthreads();
        mini_gemm<22, true, false, true>((const bf16*)(ws + WS_H), (const bf16*)(ws + WS_WD), DMODEL, 0, G, bid, lds, tid, mef::Out{(const bf16*)(ws + WS_XB2), out});
#endif
        __syncthreads();
        pg8::Gemm g{(const bf16*)(ws + WS_H), (const bf16*)(ws + WS_WD), MP, DMODEL, FF, 64, (size_t)MTOT * 128}; pg8::StaticOrder S; S.init(MP, DMODEL, G, bid);
        ep::EpiOut E{(const bf16*)(ws + WS_XB2), out};
        pg8::gemm_phase<ep::EpiOut, pg8::StaticOrder, true, true>(lds, g, S, E);
#if MK_DBL == 10
        __syncthreads(); pg8::gemm_phase<ep::EpiOut, pg8::StaticOrder, true, true>(lds, g, S, E);
#endif
    }
#undef IN
#undef BOTH
}

extern "C" void kernel_launch(void* const* d_in, const int* in_sizes, int n_in, void* d_out, int out_size, void* d_ws, size_t ws_size, hipStream_t stream) {
    static int grid = 0;
    if (grid == 0) {
        if (n_in != N_IN || (size_t)out_size != O_END || ws_size < WS_END) { fprintf(stderr, "kernel_launch: unexpected sizes n_in %d out %d ws %zu (need %zu)\n", n_in, out_size, ws_size, (size_t)WS_END); grid = -1; return; }
        int dev = 0, cus = 0;
        if (hipGetDevice(&dev) != hipSuccess || hipDeviceGetAttribute(&cus, hipDeviceAttributeMultiprocessorCount, dev) != hipSuccess) { grid = -1; return; }
        if (hipFuncSetAttribute((const void*)mk_fwd, hipFuncAttributeMaxDynamicSharedMemorySize, LDS_BYTES) != hipSuccess) { fprintf(stderr, "kernel_launch: hipFuncSetAttribute failed\n"); grid = -1; return; }
        int per_cu = 0;
        if (hipOccupancyMaxActiveBlocksPerMultiprocessor(&per_cu, (const void*)mk_fwd, 512, LDS_BYTES) != hipSuccess || per_cu < 1) fprintf(stderr, "kernel_launch: occupancy query says %d\n", per_cu);
        (void)hipGetLastError();
        grid = cus;
    }
    if (grid < 0) return;
    (void)hipMemsetAsync((char*)d_ws + WS_CTL, 0, CTL_ZERO_BYTES, stream);
#if MK_PH_END < 10
    (void)hipMemsetAsync(d_out, 0, (size_t)out_size * 4, stream);
#endif
    Args a{};
    for (int i = 0; i < N_IN; ++i) a.in[i] = d_in[i];
    a.out = (float*)d_out; a.ws = (unsigned char*)d_ws;
#if MK_ONE_LAUNCH
    a.ph_lo = 0; a.ph_hi = N_PHASES;
    hipLaunchKernelGGL(mk_fwd, dim3(grid), dim3(512), LDS_BYTES, stream, a);
#else
    for (int p = 0; p < N_PHASES; ++p) { a.ph_lo = p; a.ph_hi = p + 1; hipLaunchKernelGGL(mk_fwd, dim3(grid), dim3(512), LDS_BYTES, stream, a); }
#endif
}
```
